# Optimizing an MI355X kernel written in HIP

```python
import math
import jax, jax.numpy as jnp
from jax import lax
import numpy as np

D_MODEL = 1024
BATCH = 32
SEQ = 2048
DEPTH = 4

N_META = 16
BLK = 128
WINDOW = 128
HEAD_DIM = 64
A_HEADS = 8
A_KV_HEADS = 2
B_HEADS = 8
C_HEADS = 8
C_Q_RANK = 256
C_KV_RANK = 128
C_NOPE = 64
C_ROPE = 32
C_V = 64
ROPE_THETA = 10000.0
N_BRANCH = 3
BRANCH_W = 512
EPS = 1e-6
NEG = -1e30

A_Q = A_HEADS * HEAD_DIM
A_KV = A_KV_HEADS * HEAD_DIM
B_QKV = B_HEADS * HEAD_DIM
SPLITS = (A_Q, A_KV, A_KV, B_QKV, B_QKV, B_QKV, B_HEADS,
          C_Q_RANK, C_KV_RANK, C_ROPE, N_BRANCH * BRANCH_W, N_BRANCH * D_MODEL)
D_IN = sum(SPLITS)
SPLIT_IDX = tuple(int(v) for v in np.cumsum(SPLITS)[:-1])

kernel_name = 'hybrid_swa_fox_mla_gated_trunk'


def rmsnorm(x, g):
    xf = x.astype(jnp.float32)
    y = xf * lax.rsqrt(jnp.mean(xf * xf, axis=-1, keepdims=True) + EPS)
    return (y * g.astype(jnp.float32)).astype(x.dtype)


def alibi_slopes(n):
    return 2.0 ** (-8.0 * (jnp.arange(n, dtype=jnp.float32) + 1.0) / n)


def rope(x, pos):
    half = x.shape[-1] // 2
    inv = ROPE_THETA ** (-jnp.arange(half, dtype=jnp.float32) / half)
    ang = pos[:, None] * inv[None, :]
    cos = jnp.cos(ang)[None, :, None, :]
    sin = jnp.sin(ang)[None, :, None, :]
    xf = x.astype(jnp.float32)
    x1, x2 = xf[..., :half], xf[..., half:]
    return jnp.concatenate([x1 * cos - x2 * sin, x2 * cos + x1 * sin], axis=-1).astype(x.dtype)


def swa_sink_attention(q, k, v, sinks, valid):
    b, L, hq, d = q.shape
    hkv = k.shape[2]
    grp = hq // hkv
    nb = L // BLK
    qr = q.reshape(b, nb, BLK, hkv, grp, d)

    def band(t):
        tb = t.reshape(b, nb, BLK, hkv, t.shape[-1])
        prev = jnp.concatenate([jnp.zeros_like(tb[:, :1]), tb[:, :-1]], axis=1)
        return jnp.concatenate([prev, tb], axis=2)

    kw, vw = band(k), band(v)
    vb = valid.reshape(nb, BLK)
    vprev = jnp.concatenate([jnp.zeros((1, BLK), dtype=bool), vb[:-1]], axis=0)
    validk = jnp.concatenate([vprev, vb], axis=1)
    dist = BLK + jnp.arange(BLK)[:, None] - jnp.arange(2 * BLK)[None, :]
    mask = ((dist >= 0) & (dist < WINDOW))[None] & validk[:, None, :]
    slopes = alibi_slopes(hq).reshape(hkv, grp)
    s = jnp.einsum('bnqhgd,bnshd->bnhgqs', qr, kw).astype(jnp.float32) * (d ** -0.5)
    s = s - slopes[:, :, None, None] * dist.astype(jnp.float32)
    s = jnp.where(mask[None, :, None, None], s, NEG)
    sink = jnp.broadcast_to(sinks.astype(jnp.float32).reshape(hkv, grp)[None, None, :, :, None, None],
                            s.shape[:-1] + (1,))
    p = jax.nn.softmax(jnp.concatenate([s, sink], axis=-1), axis=-1)[..., :-1].astype(v.dtype)
    o = jnp.einsum('bnhgqs,bnshd->bnqhgd', p, vw)
    return o.reshape(b, L, hq * d)


def dense_causal_attention(q, k, v, valid, scale, log_cum=None):
    b, L, h, _ = q.shape
    nb = L // BLK
    idx = jnp.arange(L)
    fh = None if log_cum is None else jnp.transpose(log_cum, (0, 2, 1))
    outs = []
    for i in range(nb):
        lo, hi = i * BLK, (i + 1) * BLK
        s = jnp.einsum('bqhd,bkhd->bhqk', q[:, lo:hi], k[:, :hi]).astype(jnp.float32) * scale
        if fh is not None:
            s = s + (fh[:, :, lo:hi, None] - fh[:, :, None, :hi])
        mask = (idx[None, :hi] <= idx[lo:hi, None]) & valid[None, :hi]
        s = jnp.where(mask[None, None], s, NEG)
        p = jax.nn.softmax(s, axis=-1).astype(v.dtype)
        outs.append(jnp.einsum('bhqk,bkhd->bqhd', p, v[:, :hi]))
    return jnp.concatenate(outs, axis=1).reshape(b, L, -1)


def hybrid_layer(x, pos, valid, norm_g, w_in, b_f, sinks, q_norm_g, kv_norm_g, w_uq, w_ukv, w_br, w_out):
    b, L, _ = x.shape
    h = rmsnorm(x, norm_g)
    (aq, ak, av, bq, bk, bv, bfl, cq, ckv, ckr, z, g) = jnp.split(h @ w_in, SPLIT_IDX, axis=-1)

    oa = swa_sink_attention(aq.reshape(b, L, A_HEADS, HEAD_DIM),
                            ak.reshape(b, L, A_KV_HEADS, HEAD_DIM),
                            av.reshape(b, L, A_KV_HEADS, HEAD_DIM), sinks, valid)

    logf = jax.nn.log_sigmoid((bfl + b_f).astype(jnp.float32))
    logf = jnp.where(valid[None, :, None], logf, 0.0)
    fcum = jnp.cumsum(logf, axis=1)
    ob = dense_causal_attention(bq.reshape(b, L, B_HEADS, HEAD_DIM),
                                bk.reshape(b, L, B_HEADS, HEAD_DIM),
                                bv.reshape(b, L, B_HEADS, HEAD_DIM),
                                valid, HEAD_DIM ** -0.5, fcum)

    qc = (rmsnorm(cq, q_norm_g) @ w_uq).reshape(b, L, C_HEADS, C_NOPE + C_ROPE)
    kvc = (rmsnorm(ckv, kv_norm_g) @ w_ukv).reshape(b, L, C_HEADS, C_NOPE + C_V)
    k_rope = rope(ckr[:, :, None, :], pos)
    qc = jnp.concatenate([qc[..., :C_NOPE], rope(qc[..., C_NOPE:], pos)], axis=-1)
    kc = jnp.concatenate([kvc[..., :C_NOPE],
                          jnp.broadcast_to(k_rope, (b, L, C_HEADS, C_ROPE))], axis=-1)
    oc = dense_causal_attention(qc, kc, kvc[..., C_NOPE:], valid, (C_NOPE + C_ROPE) ** -0.5)

    zs = jnp.split(z, N_BRANCH, axis=-1)
    gs = jnp.split(g, N_BRANCH, axis=-1)
    branches = (oa, ob, oc)
    y = jax.nn.sigmoid(gs[0]) * ((branches[0] * jax.nn.silu(zs[0])) @ w_br[0])
    for i in range(1, N_BRANCH):
        y = y + jax.nn.sigmoid(gs[i]) * ((branches[i] * jax.nn.silu(zs[i])) @ w_br[i])
    return x + y @ w_out


def setup_inputs(seed: int = 0) -> dict:
    key = jax.random.key(seed)
    ks = jax.random.split(key, 13)
    f32 = jnp.float32
    x = jax.random.normal(ks[0], (BATCH, SEQ, D_MODEL), f32)
    meta_tokens = jax.random.normal(ks[1], (N_META, D_MODEL), f32)
    norm_g = 1.0 + 0.05 * jax.random.normal(ks[2], (DEPTH, D_MODEL), f32)
    w_in = jax.random.normal(ks[3], (DEPTH, D_MODEL, D_IN), f32) * D_MODEL ** -0.5
    b_f = 1.0 + 3.0 * jax.random.uniform(ks[4], (DEPTH, B_HEADS), f32)
    sinks = 0.5 * jax.random.normal(ks[5], (DEPTH, A_HEADS), f32)
    q_norm_g = 1.0 + 0.05 * jax.random.normal(ks[6], (DEPTH, C_Q_RANK), f32)
    kv_norm_g = 1.0 + 0.05 * jax.random.normal(ks[7], (DEPTH, C_KV_RANK), f32)
    w_uq = jax.random.normal(ks[8], (DEPTH, C_Q_RANK, C_HEADS * (C_NOPE + C_ROPE)), f32) * C_Q_RANK ** -0.5
    w_ukv = jax.random.normal(ks[9], (DEPTH, C_KV_RANK, C_HEADS * (C_NOPE + C_V)), f32) * C_KV_RANK ** -0.5
    w_br = jax.random.normal(ks[10], (DEPTH, N_BRANCH, BRANCH_W, D_MODEL), f32) * BRANCH_W ** -0.5
    w_out = jax.random.normal(ks[11], (DEPTH, D_MODEL, D_MODEL), f32) * D_MODEL ** -0.5
    final_norm_g = 1.0 + 0.05 * jax.random.normal(ks[12], (D_MODEL,), f32)
    return {'x': x, 'meta_tokens': meta_tokens, 'norm_g': norm_g, 'w_in': w_in, 'b_f': b_f,
            'sinks': sinks, 'q_norm_g': q_norm_g, 'kv_norm_g': kv_norm_g, 'w_uq': w_uq,
            'w_ukv': w_ukv, 'w_br': w_br, 'w_out': w_out, 'final_norm_g': final_norm_g}


def reference(x, meta_tokens, norm_g, w_in, b_f, sinks, q_norm_g, kv_norm_g, w_uq, w_ukv, w_br, w_out, final_norm_g):
    b = x.shape[0]
    pad = BLK - N_META
    h = jnp.concatenate([jnp.zeros((b, pad, D_MODEL), x.dtype),
                         jnp.broadcast_to(meta_tokens[None].astype(x.dtype), (b, N_META, D_MODEL)),
                         x], axis=1)
    L = h.shape[1]
    idx = jnp.arange(L)
    pos = (idx - pad).astype(jnp.float32)
    valid = idx >= pad
    for l in range(DEPTH):
        h = hybrid_layer(h, pos, valid, norm_g[l], w_in[l], b_f[l], sinks[l], q_norm_g[l],
                         kv_norm_g[l], w_uq[l], w_ukv[l], w_br[l], w_out[l])
    return rmsnorm(h[:, BLK:], final_norm_g)
```

```cpp
#include <hip/hip_runtime.h>
#include <hip/hip_cooperative_groups.h>
#include <cstdio>
#include <cstdint>
namespace cg = cooperative_groups;

#define LAS __attribute__((address_space(3)))
#define GAS __attribute__((address_space(1)))
typedef unsigned short bf16_t;
typedef short bf16x8 __attribute__((ext_vector_type(8)));
typedef short s16x4 __attribute__((ext_vector_type(4)));
typedef float f32x4 __attribute__((ext_vector_type(4)));
typedef float f32x2 __attribute__((ext_vector_type(2)));
typedef unsigned u32x4 __attribute__((ext_vector_type(4)));
typedef unsigned u32x2 __attribute__((ext_vector_type(2)));

constexpr int NBATCH = 32, T = 2048, D = 1024, DEPTH = 4, NMETA = 16;
constexpr int CB = 16, NCHUNK = NBATCH / CB;
constexpr int MR = CB * T;
constexpr int MC = MR + CB * NMETA;
constexpr int DIN = 7336, NIN = 7424, LDP = 6912;
constexpr int NPOS = NMETA + T;
constexpr float EPS = 1e-6f;
constexpr float LOG2E = 1.4426950408889634f;
constexpr float QS64 = 0.125f * LOG2E;
constexpr float QS96 = 0.10206207261596577f * LOG2E;
constexpr int PC_Z = 2304, PC_G = 3840;

constexpr size_t al256(size_t x) { return (x + 255) & ~(size_t)255; }
constexpr size_t WS_CTL = 0, CTL_BYTES = 24576;
constexpr size_t SZ_WIN = (size_t)NIN * D * 2, SZ_WUQ = (size_t)768 * 256 * 2, SZ_WUKV = (size_t)1024 * 128 * 2, SZ_WBR = (size_t)3 * 1024 * 512 * 2, SZ_WOUT = (size_t)1024 * 1024 * 2;
constexpr size_t WS_WIN = 24576;
constexpr size_t WS_WUQ = WS_WIN + DEPTH * SZ_WIN;
constexpr size_t WS_WUKV = WS_WUQ + DEPTH * SZ_WUQ;
constexpr size_t WS_WBR = WS_WUKV + DEPTH * SZ_WUKV;
constexpr size_t WS_WOUT = WS_WBR + DEPTH * SZ_WBR;
constexpr size_t WS_ROPE = WS_WOUT + DEPTH * SZ_WOUT;
constexpr size_t WS_XB = al256(WS_ROPE + (size_t)NPOS * 16 * 8);
constexpr size_t WS_P = al256(WS_XB + (size_t)NCHUNK * MC * 1024 * 2);
constexpr size_t WS_QC = al256(WS_P + (size_t)MC * LDP * 2);
constexpr size_t WS_KVC = WS_QC + (size_t)MC * 768 * 2;
constexpr size_t WS_CQ = WS_KVC + (size_t)MC * 1024 * 2;
constexpr size_t WS_YACC = WS_QC;
static_assert((size_t)MC * 1024 * 4 <= (size_t)MC * (768 + 1024 + 256) * 2, "Yacc overlay");
constexpr size_t WS_CKV = al256(WS_CQ + (size_t)MC * 256 * 2);
constexpr size_t WS_KR = al256(WS_CKV + (size_t)MC * 128 * 2);
constexpr size_t WS_BFL = al256(WS_KR + (size_t)MC * 32 * 2);
constexpr size_t WS_FC = al256(WS_BFL + (size_t)MC * 8 * 4);
constexpr size_t WS_OZ = al256(WS_FC + (size_t)MC * 8 * 4);
constexpr size_t WS_Y = al256(WS_OZ + (size_t)3 * MC * 512 * 2);
constexpr size_t WS_XM = al256(WS_Y + (size_t)MC * 1024 * 2);
constexpr size_t WS_SSQX = al256(WS_XM + (size_t)256 * 1024 * 4);
constexpr size_t WS_SSQQ = al256(WS_SSQX + (size_t)NCHUNK * MC * 16 * 4);
constexpr size_t WS_SSQKV = al256(WS_SSQQ + (size_t)MC * 4 * 4);
constexpr size_t WS_END = al256(WS_SSQKV + (size_t)MC * 4 * 4);
static_assert(WS_END <= (size_t)1 << 30, "workspace map must fit 1 GiB");

constexpr int LDS_RING = 131072, LDS_MISC = LDS_RING, LDS_RS = LDS_RING + 64, LDS_PART = LDS_RING + 2048, LDS_BYTES = LDS_RING + 2048 + 16384;

typedef __bf16 bf16x2_t __attribute__((ext_vector_type(2)));
__device__ __forceinline__ unsigned cvt_pk_bf16(float lo, float hi) { f32x2 v = {lo, hi}; bf16x2_t b = __builtin_convertvector(v, bf16x2_t); return __builtin_bit_cast(unsigned, b); }
__device__ __forceinline__ float bf2f(unsigned short h) { return __uint_as_float((unsigned)h << 16); }
__device__ __forceinline__ float bflo(unsigned w) { return __uint_as_float(w << 16); }
__device__ __forceinline__ float bfhi(unsigned w) { return __uint_as_float(w & 0xffff0000u); }
__device__ __forceinline__ int lane_id_v() { int l; asm volatile("v_mbcnt_lo_u32_b32 %0, -1, 0\n\tv_mbcnt_hi_u32_b32 %0, -1, %0" : "=v"(l)); return l; }
__device__ __forceinline__ int row_pos(int m) { return m < MR ? NMETA + (m & (T - 1)) : ((m - MR) & (NMETA - 1)); }
__device__ __forceinline__ float wave_sum(float v, int lane) {
#pragma unroll
    for (int o = 1; o < 64; o <<= 1) v += __int_as_float(__builtin_amdgcn_ds_bpermute((lane ^ o) << 2, __float_as_int(v)));
    return v;
}

namespace pg8 {
constexpr int BM = 256, BK = 64, HALF = 128, HTB = HALF * BK * 2, STAGE_BYTES = 8 * HTB, NXCD = 8, WGM = 8;
__host__ __device__ __forceinline__ int lds_byte(int r, int c) { const int st = (r >> 4) * 2 + (c >> 5), rr = r & 15, cc = c & 31, ob = rr * 64 + cc * 2; return st * 1024 + (ob ^ (((ob >> 9) & 1) << 5)); }
__host__ __device__ __forceinline__ void stage_rc(int b, int& R, int& C) { const int st = b / 1024, sb = b % 1024, swz = sb ^ (((sb >> 9) & 1) << 5); R = (st >> 1) * 16 + swz / 64; C = (st & 1) * 32 + (swz % 64) / 2; }
__host__ __device__ __forceinline__ int perm32(int rho) { const int n = rho >> 4, i = rho & 15; return 8 * (i >> 2) + 4 * n + (i & 3); }

struct Unit { int pm, pn, z; };
struct Gemm { const bf16_t* A; const bf16_t* Bt; int M, N, K; size_t zA, zB; };

struct StaticOrder {
    int nM, nN, nwg, G, c, NZ;
    __device__ void init(int M, int N, int G_, int c_, int NZ_, int BN_ = BM) { nM = M / BM; nN = N / BN_; nwg = nM * nN; G = G_; c = c_; NZ = NZ_; }
    __device__ bool next(int i, Unit& u) const {
        const int it = i / NZ; u.z = i - it * NZ;
        const long L = (long)it * G + c; if (L >= nwg) return false;
        int wgid = (int)L; { const int q = nwg / NXCD, r = nwg % NXCD, xcd = wgid % NXCD, off = wgid / NXCD; wgid = (xcd < r ? xcd * (q + 1) : r * (q + 1) + (xcd - r) * q) + off; }
        const int nig = WGM * nN, gid = wgid / nig, fm = gid * WGM, gsz = (nM - fm) < WGM ? (nM - fm) : WGM;
        u.pm = fm + ((wgid % nig) % gsz); u.pn = (wgid % nig) / gsz; return true;
    }
};

template <class Epi, class Sched, bool HALFN = false>
__device__ __forceinline__ void gemm_phase(LAS unsigned char* lds, const Gemm g, const Sched& S, const Epi& E, int wave_s) {
    const int lane = lane_id_v(), wid = wave_s, tid = wid * 64 + lane, wr = wid >> 2, wc = wid & 3, fr = lane & 15, fq = lane >> 4;
    const int K = g.K, nt = K / BK;
    unsigned voffA[2], voffB[2];
#pragma unroll
    for (int i = 0; i < 2; ++i) { int R, C; stage_rc(tid * 16 + i * 8192, R, C); const int Rb = (R & ~31) + perm32(R & 31);
        voffA[i] = (unsigned)(R * K + C) * 2u; voffB[i] = (unsigned)(Rb * K + C) * 2u; }
    const size_t kstep = (size_t)(BK * 2);
    const size_t hstep = (size_t)HALF * K * 2;
    const size_t tstep = 2 * hstep;
    const unsigned ldsw = (unsigned)wid * 1024u;
#define PG8_SA(b, h) (((b) * 2 + (h)) * HTB)
#define PG8_SB(b, h) ((4 + (b) * 2 + (h)) * HTB)
#define PG8_STAGE(bufoff, gbase, voff) do { _Pragma("unroll") for (int _i = 0; _i < 2; ++_i) \
        __builtin_amdgcn_global_load_lds((const unsigned*)((const char*)(gbase) + (voff)[_i]), (LAS unsigned*)(lds + (bufoff) + ldsw + _i * 8192), 16, 0, 0); } while (0)
#define PG8_LDA(dst, b, h) do { _Pragma("unroll") for (int m = 0; m < 4; ++m) _Pragma("unroll") for (int k = 0; k < 2; ++k) dst[m][k] = *(const LAS bf16x8*)(lds + PG8_SA(b, h) + aoff + m * 2048 + k * 1024); } while (0)
#define PG8_LDB(dst, b, h) do { _Pragma("unroll") for (int n = 0; n < 2; ++n) _Pragma("unroll") for (int k = 0; k < 2; ++k) dst[n][k] = *(const LAS bf16x8*)(lds + PG8_SB(b, h) + boff + n * 2048 + k * 1024); } while (0)
#define PG8_MMA(ai, bj, At, Bt) do { __builtin_amdgcn_s_setprio(1); _Pragma("unroll") for (int m = 0; m < 4; ++m) _Pragma("unroll") for (int n = 0; n < 2; ++n) _Pragma("unroll") for (int k = 0; k < 2; ++k) \
        acc[ai][bj][m][n] = __builtin_amdgcn_mfma_f32_16x16x32_bf16(Bt[n][k], At[m][k], acc[ai][bj][m][n], 0, 0, 0); __builtin_amdgcn_s_setprio(0); } while (0)
#define PG8_WAIT_V(n) asm volatile("s_waitcnt vmcnt(" #n ")" ::: "memory")
#define PG8_WAIT_L(n) asm volatile("s_waitcnt lgkmcnt(" #n ")" ::: "memory")
#define PG8_BAR __builtin_amdgcn_s_barrier()
#define PG8_SCHED __builtin_amdgcn_sched_barrier(0)
    Unit cur, nxt; int ui = 0;
    if (!S.next(0, cur)) return;
    if constexpr (Epi::PREFETCH) E.prefetch(cur, wid, lane);
    f32x4 acc[2][2][4][2];
#pragma unroll
    for (int a = 0; a < 2; ++a)
#pragma unroll
        for (int b = 0; b < 2; ++b)
#pragma unroll
            for (int m = 0; m < 4; ++m)
#pragma unroll
                for (int n = 0; n < 2; ++n) acc[a][b][m][n] = (f32x4){0.f, 0.f, 0.f, 0.f};
    f32x4 yacc[2][4][2]; u32x4 gpre[8];
    if constexpr (HALFN) E.gates(cur, wr, wc, lane, gpre);
    if constexpr (HALFN) {
#pragma unroll
        for (int a = 0; a < 2; ++a)
#pragma unroll
            for (int m = 0; m < 4; ++m)
#pragma unroll
                for (int n = 0; n < 2; ++n) yacc[a][m][n] = (f32x4){0.f, 0.f, 0.f, 0.f};
    }
    bf16x8 At[4][2], B0[2][2], B1[2][2];
    const char* cA = (const char*)g.A + (size_t)cur.z * g.zA * 2 + (size_t)cur.pm * tstep; const char* cB = (const char*)g.Bt + (size_t)cur.z * g.zB * 2 + (size_t)cur.pn * (HALFN ? hstep : tstep);
    const size_t bh1 = HALFN ? 0 : hstep;
    PG8_STAGE(PG8_SB(0, 0), cB, voffB); PG8_STAGE(PG8_SB(0, 1), cB + bh1, voffB); PG8_STAGE(PG8_SA(0, 0), cA, voffA); PG8_STAGE(PG8_SA(0, 1), cA + hstep, voffA);
    if (wr == 1) PG8_BAR;
    PG8_WAIT_V(2); PG8_BAR;
    PG8_STAGE(PG8_SB(1, 0), cB + kstep, voffB); PG8_STAGE(PG8_SA(1, 0), cA + kstep, voffA); PG8_STAGE(PG8_SB(1, 1), cB + bh1 + kstep, voffB);
    PG8_WAIT_V(6); PG8_BAR;
    const int l3 = lane_id_v();
    const int aoff = lds_byte(wr * 64 + (l3 & 15), (l3 >> 4) * 8), boff = lds_byte(wc * 32 + (l3 & 15), (l3 >> 4) * 8);
    for (;;) {
        const bool has_next = S.next(ui + 1, nxt);
        const char* nA = has_next ? (const char*)g.A + (size_t)nxt.z * g.zA * 2 + (size_t)nxt.pm * tstep : cA; const char* nB = has_next ? (const char*)g.Bt + (size_t)nxt.z * g.zB * 2 + (size_t)nxt.pn * (HALFN ? hstep : tstep) : cB;
        for (int t = 0; t < nt; t += 2) {
            const bool last = (t == nt - 2);
            const char* a1 = cA + (size_t)(t + 1) * kstep;
            const char* a2 = last ? nA : cA + (size_t)(t + 2) * kstep; const char* b2 = last ? nB : cB + (size_t)(t + 2) * kstep;
            const char* a3 = a2 + kstep; const char* b3 = b2 + kstep;
            PG8_LDB(B0, 0, 0); if (!HALFN) PG8_LDB(B1, 0, 1); PG8_SCHED; PG8_LDA(At, 0, 0); PG8_STAGE(PG8_SA(1, 1), a1 + hstep, voffA);
            PG8_WAIT_V(8); PG8_WAIT_L(0); PG8_BAR; PG8_MMA(0, 0, At, B0); if (!HALFN) PG8_MMA(0, 1, At, B1); PG8_BAR; PG8_SCHED;
            PG8_LDA(At, 0, 1); PG8_STAGE(PG8_SB(0, 0), b2, voffB); PG8_STAGE(PG8_SB(0, 1), b2 + bh1, voffB); PG8_STAGE(PG8_SA(0, 0), a2, voffA);
            PG8_WAIT_V(8); PG8_WAIT_L(0); PG8_BAR; PG8_MMA(1, 0, At, B0); if (!HALFN) PG8_MMA(1, 1, At, B1); PG8_BAR; PG8_SCHED;
            PG8_LDB(B0, 1, 0); if (!HALFN) PG8_LDB(B1, 1, 1); PG8_SCHED; PG8_LDA(At, 1, 0); PG8_STAGE(PG8_SA(0, 1), a2 + hstep, voffA);
            PG8_WAIT_V(8); PG8_WAIT_L(0); PG8_BAR; PG8_MMA(0, 0, At, B0); if (!HALFN) PG8_MMA(0, 1, At, B1); PG8_BAR; PG8_SCHED;
            PG8_LDA(At, 1, 1); PG8_STAGE(PG8_SB(1, 0), b3, voffB); PG8_STAGE(PG8_SB(1, 1), b3 + bh1, voffB); PG8_STAGE(PG8_SA(1, 0), a3, voffA);
            PG8_WAIT_V(8); PG8_WAIT_L(0); PG8_BAR; PG8_MMA(1, 0, At, B0); if (!HALFN) PG8_MMA(1, 1, At, B1); PG8_BAR; PG8_SCHED;
        }
        if (wr == 0) PG8_BAR;
        { const int l2 = lane_id_v(), fr2 = l2 & 15, fq2 = l2 >> 4;
          if constexpr (HALFN) E.accum(acc, yacc, gpre, cur, wr, wc, fr2, fq2); else E(acc, cur, wr, wc, fr2, fq2); }
        if (!has_next) break;
#pragma unroll
        for (int a = 0; a < 2; ++a)
#pragma unroll
            for (int b = 0; b < 2; ++b)
#pragma unroll
                for (int m = 0; m < 4; ++m)
#pragma unroll
                    for (int n = 0; n < 2; ++n) acc[a][b][m][n] = (f32x4){0.f, 0.f, 0.f, 0.f};
        cur = nxt; cA = nA; cB = nB; ++ui;
        if constexpr (Epi::PREFETCH) E.prefetch(cur, wid, lane_id_v());
        if constexpr (HALFN) E.gates(cur, wr, wc, lane_id_v(), gpre);
        if (wr == 1) PG8_BAR;
    }
    PG8_WAIT_V(0);
    PG8_BAR;
#undef PG8_SA
#undef PG8_SB
#undef PG8_STAGE
#undef PG8_LDA
#undef PG8_LDB
#undef PG8_MMA
#undef PG8_WAIT_V
#undef PG8_WAIT_L
#undef PG8_BAR
#undef PG8_SCHED
}
}
using pg8::Unit;

__device__ __forceinline__ u32x4 pack8(const f32x4& v0, const f32x4& v1) { u32x4 w; w.x = cvt_pk_bf16(v0[0], v0[1]); w.y = cvt_pk_bf16(v0[2], v0[3]); w.z = cvt_pk_bf16(v1[0], v1[1]); w.w = cvt_pk_bf16(v1[2], v1[3]); return w; }
__device__ __forceinline__ float sumsq8(const f32x4& a, const f32x4& b) { return (a[0] * a[0] + a[1] * a[1]) + (a[2] * a[2] + a[3] * a[3]) + (b[0] * b[0] + b[1] * b[1]) + (b[2] * b[2] + b[3] * b[3]); }
__device__ __forceinline__ float max3f(float a, float b, float c) { return __builtin_fmaxf(__builtin_fmaxf(a, b), c); }
__device__ __forceinline__ float quad_max(float v) {
    auto a = __builtin_amdgcn_permlane16_swap(__float_as_uint(v), __float_as_uint(v), false, false);
    v = fmaxf(__uint_as_float(a[0]), __uint_as_float(a[1]));
    auto c = __builtin_amdgcn_permlane32_swap(__float_as_uint(v), __float_as_uint(v), false, false);
    return fmaxf(__uint_as_float(c[0]), __uint_as_float(c[1]));
}
__device__ __forceinline__ float quad_sum(float v) {
    auto a = __builtin_amdgcn_permlane16_swap(__float_as_uint(v), __float_as_uint(v), false, false);
    v = __uint_as_float(a[0]) + __uint_as_float(a[1]);
    auto c = __builtin_amdgcn_permlane32_swap(__float_as_uint(v), __float_as_uint(v), false, false);
    return __uint_as_float(c[0]) + __uint_as_float(c[1]);
}
__device__ __forceinline__ void rope8(f32x4& v0, f32x4& v1, const f32x2* rope, int p, int i0) {
    const f32x2* rp = rope + p * 16 + i0;
    const f32x2 c0 = rp[0], c1 = rp[1], c2 = rp[2], c3 = rp[3];
    f32x4 o0, o1;
    o0[0] = v0[0] * c0.x - v0[1] * c0.y; o0[1] = v0[1] * c0.x + v0[0] * c0.y;
    o0[2] = v0[2] * c1.x - v0[3] * c1.y; o0[3] = v0[3] * c1.x + v0[2] * c1.y;
    o1[0] = v1[0] * c2.x - v1[1] * c2.y; o1[1] = v1[1] * c2.x + v1[0] * c2.y;
    o1[2] = v1[2] * c3.x - v1[3] * c3.y; o1[3] = v1[3] * c3.x + v1[2] * c3.y;
    v0 = o0; v1 = o1;
}

template <int NP> __device__ __forceinline__ void unit_prefetch(LAS unsigned char* lds, const float* SSQ, int pm, int wid, int lane) {
    const int tid = wid * 64 + lane;
    if (NP == 16) {
        const float* src = SSQ + (size_t)(pm * 256 + (tid >> 1)) * 16 + (tid & 1) * 8;
        __builtin_amdgcn_global_load_lds((const unsigned*)src, (LAS unsigned*)(lds + LDS_PART + wid * 1024), 16, 0, 0);
        __builtin_amdgcn_global_load_lds((const unsigned*)(src + 4), (LAS unsigned*)(lds + LDS_PART + 8192 + wid * 1024), 16, 0, 0);
    } else {
        if (wid < 4) __builtin_amdgcn_global_load_lds((const unsigned*)(SSQ + (size_t)(pm * 256 + tid) * 4), (LAS unsigned*)(lds + LDS_PART + wid * 1024), 16, 0, 0);
    }
}
template <int NP> __device__ __forceinline__ void unit_rstd(LAS unsigned char* lds, float inv_n, int tid_in) {
    int tid = tid_in; asm volatile("" : "+v"(tid));
    LAS float* rs = (LAS float*)(lds + LDS_RS);
    if (NP == 16) {
        const f32x4 a = *(const LAS f32x4*)(lds + LDS_PART + tid * 16), b = *(const LAS f32x4*)(lds + LDS_PART + 8192 + tid * 16);
        float ss = ((a[0] + a[1]) + (a[2] + a[3])) + ((b[0] + b[1]) + (b[2] + b[3]));
        ss += __builtin_bit_cast(float, __builtin_amdgcn_update_dpp(0, __builtin_bit_cast(int, ss), 0xB1, 0xF, 0xF, true));
        if ((tid & 1) == 0) rs[tid >> 1] = __builtin_amdgcn_rsqf(ss * inv_n + EPS);
    } else {
        if (tid < 256) { const f32x4 a = *(const LAS f32x4*)(lds + LDS_PART + tid * 16); rs[tid] = __builtin_amdgcn_rsqf(((a[0] + a[1]) + (a[2] + a[3])) * inv_n + EPS); }
    }
    asm volatile("s_waitcnt lgkmcnt(0)" ::: "memory"); __builtin_amdgcn_s_barrier(); asm volatile("" ::: "memory");
}
struct EpiIn {
    bf16_t* P; bf16_t* CQ; bf16_t* CKV; bf16_t* KR; float* BFL; const float* SSQX; float* SSQQ; float* SSQKV; const f32x2* ROPE; LAS unsigned char* lds;
    static constexpr bool PREFETCH = true;
    __device__ __forceinline__ void prefetch(const Unit& u, int wid, int lane) const { unit_prefetch<16>(lds, SSQX, u.pm, wid, lane); }
    __device__ __forceinline__ void operator()(const f32x4 (&acc)[2][2][4][2], const Unit& u, int wr, int wc, int fr, int fq) const {
        const int row0 = u.pm * 256 + wr * 64 + fr, cw = wc * 32 + 8 * fq;
        unit_rstd<16>(lds, 1.0f / 1024.0f, (wr * 4 + wc) * 64 + fq * 16 + fr);
        const LAS float* rs = (const LAS float*)(lds + LDS_RS);
#pragma unroll
        for (int ai = 0; ai < 2; ++ai)
#pragma unroll
            for (int m = 0; m < 4; ++m) {
                int row_ = row0 + ai * 128 + m * 16; asm volatile("" : "+v"(row_)); const int row = row_;
                const float rstd = rs[wr * 64 + ai * 128 + m * 16 + fr];
                f32x4 v[2][2];
#pragma unroll
                for (int bj = 0; bj < 2; ++bj) { v[bj][0] = acc[ai][bj][m][0] * rstd; v[bj][1] = acc[ai][bj][m][1] * rstd; }
                if (u.pn < 27) {
                    bf16_t* dst = P + (size_t)row * LDP + u.pn * 256 + cw;
                    *(u32x4*)(dst) = pack8(v[0][0], v[0][1]); *(u32x4*)(dst + 128) = pack8(v[1][0], v[1][1]);
                } else if (u.pn == 27) {
                    bf16_t* dst = CQ + (size_t)row * 256 + cw;
                    *(u32x4*)(dst) = pack8(v[0][0], v[0][1]); *(u32x4*)(dst + 128) = pack8(v[1][0], v[1][1]);
                    const float s = quad_sum(sumsq8(v[0][0], v[0][1]) + sumsq8(v[1][0], v[1][1]));
                    if (fq == 0) SSQQ[(size_t)row * 4 + wc] = s;
                } else {
                    *(u32x4*)(CKV + (size_t)row * 128 + cw) = pack8(v[0][0], v[0][1]);
                    const float s = quad_sum(sumsq8(v[0][0], v[0][1]));
                    if (fq == 0) SSQKV[(size_t)row * 4 + wc] = s;
                    if (wc == 0) { rope8(v[1][0], v[1][1], ROPE, row_pos(row), 4 * fq); *(u32x4*)(KR + (size_t)row * 32 + 8 * fq) = pack8(v[1][0], v[1][1]); }
                    if (wc == 1 && fq == 0) { f32x4* bp = (f32x4*)(BFL + (size_t)row * 8); bp[0] = v[1][0]; bp[1] = v[1][1]; }
                }
                }
    }
};
template <bool QROPE> struct EpiUp {
    bf16_t* O; int ldo; const float* SSQ; float inv_nk; const f32x2* ROPE; LAS unsigned char* lds;
    static constexpr bool PREFETCH = true;
    __device__ __forceinline__ void prefetch(const Unit& u, int wid, int lane) const { unit_prefetch<4>(lds, SSQ, u.pm, wid, lane); }
    __device__ __forceinline__ void operator()(const f32x4 (&acc)[2][2][4][2], const Unit& u, int wr, int wc, int fr, int fq) const {
        const int row0 = u.pm * 256 + wr * 64 + fr, col0 = u.pn * 256 + wc * 32 + 8 * fq;
        unit_rstd<4>(lds, inv_nk, (wr * 4 + wc) * 64 + fq * 16 + fr);
        const LAS float* rs = (const LAS float*)(lds + LDS_RS);
#pragma unroll
        for (int ai = 0; ai < 2; ++ai)
#pragma unroll
            for (int m = 0; m < 4; ++m) {
                int row_ = row0 + ai * 128 + m * 16; asm volatile("" : "+v"(row_)); const int row = row_;
                const float rstd = rs[wr * 64 + ai * 128 + m * 16 + fr];
#pragma unroll
                for (int bj = 0; bj < 2; ++bj) {
                    f32x4 v0 = acc[ai][bj][m][0] * rstd, v1 = acc[ai][bj][m][1] * rstd;
                    const int col = col0 + bj * 128;
                    if (QROPE) { const int off = col % 96; if (off >= 64) rope8(v0, v1, ROPE, row_pos(row), (off - 64) >> 1); }
                    *(u32x4*)(O + (size_t)row * ldo + col) = pack8(v0, v1);
                }
                }
    }
};
struct EpiBr {        static constexpr bool PREFETCH = false;
    const bf16_t* P; bf16_t* Y;
    __device__ __forceinline__ void gates(const Unit& u, int wr, int wc, int lane, u32x4 (&gp)[8]) const {
        const int fr = lane & 15, fq = lane >> 4;
        const bf16_t* gb = P + (size_t)(u.pm * 256 + wr * 64 + fr) * LDP + PC_G + u.z * 1024 + u.pn * 128 + wc * 32 + 8 * fq;
#pragma unroll
        for (int ai = 0; ai < 2; ++ai)
#pragma unroll
            for (int m = 0; m < 4; ++m) gp[ai * 4 + m] = *(const u32x4*)(gb + (size_t)(ai * 128 + m * 16) * LDP);
    }
    __device__ __forceinline__ void accum(const f32x4 (&acc)[2][2][4][2], f32x4 (&yacc)[2][4][2], const u32x4 (&gp)[8], const Unit& u, int wr, int wc, int fr, int fq) const {
        const int row0 = u.pm * 256 + wr * 64 + fr, col = u.pn * 128 + wc * 32 + 8 * fq;
        const float keep = u.z == 0 ? 0.f : 1.f;
#pragma unroll
        for (int ai = 0; ai < 2; ++ai)
#pragma unroll
            for (int m = 0; m < 4; ++m) {
                const int row = row0 + ai * 128 + m * 16;
                const u32x4 gw = gp[ai * 4 + m];
                f32x4 g0 = {bflo(gw.x), bfhi(gw.x), bflo(gw.y), bfhi(gw.y)}, g1 = {bflo(gw.z), bfhi(gw.z), bflo(gw.w), bfhi(gw.w)};
#pragma unroll
                for (int e = 0; e < 4; ++e) { g0[e] = __builtin_amdgcn_rcpf(1.0f + __builtin_amdgcn_exp2f(g0[e])); g1[e] = __builtin_amdgcn_rcpf(1.0f + __builtin_amdgcn_exp2f(g1[e])); }
#pragma unroll
                for (int e = 0; e < 4; ++e) { yacc[ai][m][0][e] = __builtin_fmaf(g0[e], acc[ai][0][m][0][e], keep * yacc[ai][m][0][e]); yacc[ai][m][1][e] = __builtin_fmaf(g1[e], acc[ai][0][m][1][e], keep * yacc[ai][m][1][e]); }
                if (u.z == 2) *(u32x4*)(Y + (size_t)row * 1024 + col) = pack8(yacc[ai][m][0], yacc[ai][m][1]);
            }
    }
};
struct EpiOut {       static constexpr bool PREFETCH = false;
    const float* res_real; const float* res_meta; int meta_mask; float* out_real; float* XM; bf16_t* XB; float* SSQX; bool feed_next;
    __device__ __forceinline__ const float* rsrc(int row) const { return row < MR ? res_real + (size_t)row * 1024 : res_meta + (size_t)((row - MR) & meta_mask) * 1024; }
    __device__ __forceinline__ void operator()(const f32x4 (&acc)[2][2][4][2], const Unit& u, int wr, int wc, int fr, int fq) const {
        const int row0 = u.pm * 256 + wr * 64 + fr, col0 = u.pn * 256 + wc * 32 + 8 * fq;
        f32x4 nx[4];
        { int r_ = row0; asm volatile("" : "+v"(r_)); const float* rs = rsrc(r_) + col0; nx[0] = *(const f32x4*)(rs); nx[1] = *(const f32x4*)(rs + 4); nx[2] = *(const f32x4*)(rs + 128); nx[3] = *(const f32x4*)(rs + 132); }
#pragma unroll
        for (int ai = 0; ai < 2; ++ai)
#pragma unroll
            for (int m = 0; m < 4; ++m) {
                int row_ = row0 + ai * 128 + m * 16; asm volatile("" : "+v"(row_)); const int row = row_;
                f32x4 cu[4] = {nx[0], nx[1], nx[2], nx[3]};
                if (ai * 4 + m < 7) { const int it = ai * 4 + m + 1; int r_ = row0 + (it >> 2) * 128 + (it & 3) * 16; asm volatile("" : "+v"(r_)); const float* rs = rsrc(r_) + col0;
                    nx[0] = *(const f32x4*)(rs); nx[1] = *(const f32x4*)(rs + 4); nx[2] = *(const f32x4*)(rs + 128); nx[3] = *(const f32x4*)(rs + 132); }
                float* rd = row < MR ? out_real + (size_t)row * 1024 : XM + (size_t)(row - MR) * 1024;
                float s = 0.f;
#pragma unroll
                for (int bj = 0; bj < 2; ++bj) {
                    const int col = col0 + bj * 128;
                    const f32x4 x0 = cu[2 * bj] + acc[ai][bj][m][0], x1 = cu[2 * bj + 1] + acc[ai][bj][m][1];
                    *(f32x4*)(rd + col) = x0; *(f32x4*)(rd + col + 4) = x1;
                    if (feed_next) { *(u32x4*)(XB + (size_t)row * 1024 + col) = pack8(x0, x1); s += sumsq8(x0, x1); }
                }
                if (feed_next) { s = quad_sum(s); if (fq == 0) SSQX[(size_t)row * 16 + u.pn * 4 + wc] = s; }
                asm volatile("" ::: "memory");
            }
    }
};

struct AttnArgs { const bf16_t* P; const bf16_t* QC; const bf16_t* KVC; const bf16_t* KR; const float* FC; bf16_t* OZ; const float* sinks; const f32x2* ROPE; };
__device__ __forceinline__ int e2row(int b, int e) { return e >= 64 ? b * T + (e - 64) : (MR + b * NMETA + (e >= 48 ? e - 48 : 0)); }

typedef short v4i16_t __attribute__((ext_vector_type(4)));
template <int TY> __device__ __forceinline__ void attn_unit(LAS unsigned char* lds, const AttnArgs& a, int b, int h, int qt, int wave_s) {
    constexpr int DK = TY == 2 ? 96 : 64, NDS = DK / 32, VSTR = 80;
    constexpr int KBYTES = 64 * DK * 2, VBYTES = 64 * VSTR * 2, BUFB = KBYTES + VBYTES + 256;
    const int lane = lane_id_v(), wv = wave_s, tid = wv * 64 + lane, fr = lane & 15, fq = lane >> 4;
    const bool meta = qt < 0;
    const int eq0 = meta ? 48 : 64 + 256 * qt;
    const int J1 = meta ? 0 : 4 * qt + 4;
    const int J0 = (TY == 0 && !meta && qt > 0) ? 4 * qt - 1 : 0;
    const bf16_t *Qp, *Kp, *Vp; int qpitch, kpitch;
    if (TY == 0) { Qp = a.P + h * 64; Kp = a.P + 512 + (h >> 2) * 64; Vp = a.P + 640 + (h >> 2) * 64; qpitch = LDP; kpitch = LDP; }
    else if (TY == 1) { Qp = a.P + 768 + h * 64; Kp = a.P + 1280 + h * 64; Vp = a.P + 1792 + h * 64; qpitch = LDP; kpitch = LDP; }
    else { Qp = a.QC + h * 96; Kp = a.KVC + h * 128; Vp = a.KVC + h * 128 + 64; qpitch = 768; kpitch = 1024; }
    bf16x8 qf[2][NDS]; int eq[2];
#pragma unroll
    for (int qb = 0; qb < 2; ++qb) {
        eq[qb] = eq0 + 32 * wv + 16 * qb + fr;
        const int qrow = e2row(b, eq[qb]);
#pragma unroll
        for (int ds = 0; ds < NDS; ++ds) qf[qb][ds] = *(const bf16x8*)(Qp + (size_t)qrow * qpitch + ds * 32 + fq * 8);
        if (TY == 2) {
            const u32x4 w = __builtin_bit_cast(u32x4, qf[qb][NDS - 1]);
            f32x4 v0 = {bflo(w.x), bfhi(w.x), bflo(w.y), bfhi(w.y)}, v1 = {bflo(w.z), bfhi(w.z), bflo(w.w), bfhi(w.w)};
            rope8(v0, v1, a.ROPE, eq[qb] - 48, 4 * fq);
            qf[qb][NDS - 1] = __builtin_bit_cast(bf16x8, pack8(v0, v1));
        }
    }
    u32x2 zpre[2][4];
#pragma unroll
    for (int qb = 0; qb < 2; ++qb) {
        const bf16_t* zp = a.P + (size_t)e2row(b, eq[qb]) * LDP + PC_Z + TY * 512 + h * 64 + 4 * fq;
#pragma unroll
        for (int db = 0; db < 4; ++db) zpre[qb][db] = *(const u32x2*)(zp + 16 * db);
    }
    const float slope2 = TY == 0 ? exp2f(-(float)(h + 1)) * LOG2E : 0.f;
    constexpr float THR = 20.0f;
    float mrun[2]; f32x4 lacc[2]; f32x4 o[2][4];
    unsigned ow_ = 0x3f803f80u; asm volatile("" : "+v"(ow_));
    const u32x4 ones_w = {ow_, ow_, ow_, ow_}; const bf16x8 ones = __builtin_bit_cast(bf16x8, ones_w);
#pragma unroll
    for (int qb = 0; qb < 2; ++qb) {
        mrun[qb] = TY == 0 ? a.sinks[h] * LOG2E : 0.f; { const float l0 = TY == 0 ? 1.f : 0.f; lacc[qb] = (f32x4){l0, l0, l0, l0}; }
#pragma unroll
        for (int db = 0; db < 4; ++db) o[qb][db] = (f32x4){0.f, 0.f, 0.f, 0.f};
    }
    const int ki = tid >> 3, kc = tid & 7, ki2 = tid >> 2, kc2 = tid & 3;
    const int kwoff = ((ki >> 4) * NDS + (kc >> 2)) * 1024 + ((((ki & 15) * 64) + (kc & 3) * 16) ^ (((ki & 15) >> 3) << 5));
    const int kwoff2 = (((ki2 & 63) >> 4) * NDS + (NDS - 1)) * 1024 + ((((ki2 & 15) * 64) + kc2 * 16) ^ (((ki2 & 15) >> 3) << 5));
    u32x4 kregA, vregA, kreg2A = {0u, 0u, 0u, 0u}; float fregA = 0.f;
    u32x4 kregB = {0u, 0u, 0u, 0u}, vregB = {0u, 0u, 0u, 0u}, kreg2B = {0u, 0u, 0u, 0u}; float fregB = 0.f;
#define ATT_LOAD(S, J) do { const int r_ = e2row(b, 64 * (J) + ki); kreg##S = *(const u32x4*)(Kp + (size_t)r_ * kpitch + kc * 8); vreg##S = *(const u32x4*)(Vp + (size_t)r_ * kpitch + kc * 8); \
        if (TY == 2) { const int r2_ = e2row(b, 64 * (J) + (ki2 & 63)); kreg2##S = *(const u32x4*)(a.KR + (size_t)r2_ * 32 + kc2 * 8); } \
        if (TY == 1) { const int r3_ = e2row(b, 64 * (J) + (tid & 63)); freg##S = a.FC[(size_t)r3_ * 8 + h]; } } while (0)
#define ATT_STORE(S, buf) do { LAS unsigned char* sb_ = lds + (buf) * BUFB; \
        *(LAS u32x4*)(sb_ + kwoff) = kreg##S; \
        if (TY == 2 && tid < 256) *(LAS u32x4*)(sb_ + kwoff2) = kreg2##S; \
        *(LAS u32x4*)(sb_ + KBYTES + (ki * VSTR + kc * 8) * 2) = vreg##S; \
        if (TY == 1 && tid < 64) *(LAS float*)(sb_ + KBYTES + VBYTES + tid * 4) = freg##S; } while (0)
    ATT_LOAD(A, J0);
    ATT_STORE(A, 0);
    ATT_LOAD(B, J0 < J1 ? J0 + 1 : J1);
    __syncthreads();
    const int koff = (fr * 64 + fq * 16) ^ ((fr >> 3) << 5);
    const int voff = KBYTES + ((4 * fq + (fr >> 2)) * VSTR + 4 * (fr & 3)) * 2;
    const int ewlo = eq0 + 32 * wv, ewhi = ewlo + 31;
    for (int Jp = J0; Jp <= J1; Jp += 2) {
#pragma unroll
      for (int hf = 0; hf < 2; ++hf) {
        const int J = Jp + hf;
        if (J > J1) break;
        const int cur = hf;
        LAS unsigned char* sb = lds + cur * BUFB;
        { const int Jn = J + 2 <= J1 ? J + 2 : J1; if (hf == 0) ATT_LOAD(A, Jn); else ATT_LOAD(B, Jn); }
        const bool skip = (64 * J > ewhi) || (TY == 0 && 64 * J + 63 + 127 < ewlo);
        if (!skip) {
        int lim[2]; f32x4 cinit[2];
#pragma unroll
        for (int qb = 0; qb < 2; ++qb) {
            lim[qb] = eq[qb] - 64 * J - 4 * fq;
            const float c0 = TY == 0 ? -(mrun[qb] + slope2 * (float)lim[qb]) : -mrun[qb];
            cinit[qb] = (f32x4){c0, c0, c0, c0};
        }
        f32x4 s[2][4];
        bf16x8 kfr[4][NDS];
#pragma unroll
        for (int kb = 0; kb < 4; ++kb)
#pragma unroll
            for (int ds = 0; ds < NDS; ++ds) kfr[kb][ds] = *(const LAS bf16x8*)(sb + koff + (kb * NDS + ds) * 1024);
#pragma unroll
        for (int kb = 0; kb < 4; ++kb) {
#pragma unroll
            for (int ds = 0; ds < NDS; ++ds) {
                s[0][kb] = __builtin_amdgcn_mfma_f32_16x16x32_bf16(kfr[kb][ds], qf[0][ds], ds == 0 ? cinit[0] : s[0][kb], 0, 0, 0);
                s[1][kb] = __builtin_amdgcn_mfma_f32_16x16x32_bf16(kfr[kb][ds], qf[1][ds], ds == 0 ? cinit[1] : s[1][kb], 0, 0, 0);
            }
        }
        bf16x8 vf[4][2];
#pragma unroll
        for (int db = 0; db < 4; ++db)
#pragma unroll
            for (int G = 0; G < 2; ++G) {
                LAS unsigned char* vp = sb + voff + (32 * G * VSTR + 16 * db) * 2;
                const v4i16_t lo = __builtin_amdgcn_ds_read_tr16_b64_v4i16((LAS v4i16_t*)vp), hi = __builtin_amdgcn_ds_read_tr16_b64_v4i16((LAS v4i16_t*)(vp + 16 * VSTR * 2));
                vf[db][G] = (bf16x8){lo[0], lo[1], lo[2], lo[3], hi[0], hi[1], hi[2], hi[3]};
            }
        if (TY == 1) {
#pragma unroll
            for (int kb = 0; kb < 4; ++kb) {
                const f32x4 fk = *(const LAS f32x4*)(sb + KBYTES + VBYTES + (16 * kb + 4 * fq) * 4);
                s[0][kb] -= fk; s[1][kb] -= fk;
            }
        }
        if (TY == 0) {
#pragma unroll
            for (int kb = 0; kb < 4; ++kb)
#pragma unroll
                for (int r = 0; r < 4; ++r)
#pragma unroll
                    for (int qb = 0; qb < 2; ++qb) {
                        const float v = s[qb][kb][r] + slope2 * (float)(16 * kb + r);
                        s[qb][kb][r] = ((unsigned)(lim[qb] - (16 * kb + r)) < 128u) ? v : -1e30f;
                    }
        } else if (64 * J + 63 > ewlo) {
#pragma unroll
            for (int kb = 0; kb < 4; ++kb)
#pragma unroll
                for (int r = 0; r < 4; ++r)
#pragma unroll
                    for (int qb = 0; qb < 2; ++qb) s[qb][kb][r] = ((16 * kb + r) <= lim[qb]) ? s[qb][kb][r] : -1e30f;
        }
        if (J == 0) {
#pragma unroll
            for (int kb = 0; kb < 3; ++kb)
#pragma unroll
                for (int qb = 0; qb < 2; ++qb) s[qb][kb] = (f32x4){-1e30f, -1e30f, -1e30f, -1e30f};
        }
        bf16x8 pf[2][2];
        float mxl[2];
#pragma unroll
        for (int qb = 0; qb < 2; ++qb) {
            float mx = max3f(s[qb][0][0], s[qb][0][1], s[qb][0][2]);
            mx = max3f(mx, s[qb][0][3], s[qb][1][0]); mx = max3f(mx, s[qb][1][1], s[qb][1][2]); mx = max3f(mx, s[qb][1][3], s[qb][2][0]);
            mx = max3f(mx, s[qb][2][1], s[qb][2][2]); mx = max3f(mx, s[qb][2][3], s[qb][3][0]); mx = max3f(mx, s[qb][3][1], s[qb][3][2]); mxl[qb] = fmaxf(mx, s[qb][3][3]);
        }
        if (__any(fmaxf(mxl[0], mxl[1]) > THR)) {
#pragma unroll
            for (int qb = 0; qb < 2; ++qb) {
                const float dl = fmaxf(quad_max(mxl[qb]), 0.f);
                mrun[qb] += dl;
                const float al = __builtin_amdgcn_exp2f(-dl);
                lacc[qb] *= al;
#pragma unroll
                for (int db = 0; db < 4; ++db) o[qb][db] *= al;
#pragma unroll
                for (int kb = 0; kb < 4; ++kb) s[qb][kb] -= dl;
            }
        }
#pragma unroll
        for (int qb = 0; qb < 2; ++qb) {
#pragma unroll
            for (int kb = 0; kb < 4; ++kb)
#pragma unroll
                for (int r = 0; r < 4; ++r) s[qb][kb][r] = __builtin_amdgcn_exp2f(s[qb][kb][r]);
#pragma unroll
            for (int G = 0; G < 2; ++G) {
                u32x4 w; w.x = cvt_pk_bf16(s[qb][2 * G][0], s[qb][2 * G][1]); w.y = cvt_pk_bf16(s[qb][2 * G][2], s[qb][2 * G][3]);
                w.z = cvt_pk_bf16(s[qb][2 * G + 1][0], s[qb][2 * G + 1][1]); w.w = cvt_pk_bf16(s[qb][2 * G + 1][2], s[qb][2 * G + 1][3]);
                pf[qb][G] = __builtin_bit_cast(bf16x8, w);
            }
        }
#pragma unroll
        for (int G = 0; G < 2; ++G) {
            lacc[0] = __builtin_amdgcn_mfma_f32_16x16x32_bf16(ones, pf[0][G], lacc[0], 0, 0, 0);
            lacc[1] = __builtin_amdgcn_mfma_f32_16x16x32_bf16(ones, pf[1][G], lacc[1], 0, 0, 0);
        }
#pragma unroll
        for (int db = 0; db < 4; ++db)
#pragma unroll
            for (int G = 0; G < 2; ++G) {
                o[0][db] = __builtin_amdgcn_mfma_f32_16x16x32_bf16(vf[db][G], pf[0][G], o[0][db], 0, 0, 0);
                o[1][db] = __builtin_amdgcn_mfma_f32_16x16x32_bf16(vf[db][G], pf[1][G], o[1][db], 0, 0, 0);
            }
        }
        if (J < J1) { if (hf == 0) ATT_STORE(B, 1); else ATT_STORE(A, 0); }
        __syncthreads();
      }
    }
#undef ATT_LOAD
#undef ATT_STORE
#pragma unroll
    for (int qb = 0; qb < 2; ++qb) {
        const float inv = __builtin_amdgcn_rcpf(lacc[qb][0]);
        const bool st = !meta || (32 * wv + 16 * qb + fr) < NMETA;
        if (st) {
            const int qrow = e2row(b, eq[qb]);
            bf16_t* op = a.OZ + (size_t)TY * MC * 512 + (size_t)qrow * 512 + h * 64 + 4 * fq;
#pragma unroll
            for (int db = 0; db < 4; ++db) {
                const u32x2 zw = zpre[qb][db];
                const float z0 = bflo(zw.x), z1 = bfhi(zw.x), z2 = bflo(zw.y), z3 = bfhi(zw.y);
                const float r0 = o[qb][db][0] * inv * (z0 * __builtin_amdgcn_rcpf(1.0f + __expf(-z0))), r1 = o[qb][db][1] * inv * (z1 * __builtin_amdgcn_rcpf(1.0f + __expf(-z1)));
                const float r2 = o[qb][db][2] * inv * (z2 * __builtin_amdgcn_rcpf(1.0f + __expf(-z2))), r3 = o[qb][db][3] * inv * (z3 * __builtin_amdgcn_rcpf(1.0f + __expf(-z3)));
                u32x2 w; w.x = cvt_pk_bf16(r0, r1); w.y = cvt_pk_bf16(r2, r3);
                *(u32x2*)(op + 16 * db) = w;
            }
        }
    }
}

constexpr int ATT_GRP = 108, ATT_QUEUE = 4 * ATT_GRP;
__device__ __forceinline__ void attn_phase(LAS unsigned char* lds, const AttnArgs& a, unsigned* ctr, int wave_s, bool with_meta) {
    LAS int* slot = (LAS int*)(lds + LDS_MISC);
    const int x0 = (int)(__builtin_amdgcn_s_getreg((3 << 11) | 20) & 7u);
    for (int q = 0; q < 8; ++q) {
        const int x = (x0 + q) & 7;
        for (;;) {
            if (wave_s == 0 && lane_id_v() == 0) slot[0] = (int)atomicAdd(ctr + 16 * x, 1u);
            __syncthreads();
            const int u = slot[0];
            __syncthreads();
            if (u >= ATT_QUEUE) break;
            const int j = u / ATT_GRP, r = u - j * ATT_GRP;
            int ty, qt, bhl;
            if (r < 64) { qt = 7 - (r >> 3); ty = ((r >> 2) & 1) ? 1 : 2; bhl = r & 3; }
            else if (r < 96) { const int v = r - 64; ty = 0; qt = v >> 2; bhl = v & 3; }
            else { if (!with_meta) continue; const int v = r - 96; ty = v >> 2; qt = -1; bhl = v & 3; }
            const int bh = 4 * (x + 8 * j) + bhl, b = bh >> 3, h = bh & 7;
            if (ty == 0) attn_unit<0>(lds, a, b, h, qt, wave_s); else if (ty == 1) attn_unit<1>(lds, a, b, h, qt, wave_s); else attn_unit<2>(lds, a, b, h, qt, wave_s);
        }
    }
}

template <int KIND> __device__ __forceinline__ int src_col(int n, float& sc) {
    sc = 1.f;
    if (KIND == 0) {
        if (n < 2304) { if (n < 512 || (n >= 768 && n < 1280)) sc = QS64; return n; }
        if (n < 3840) return 2728 + (n - 2304);
        if (n < 6912) { sc = -LOG2E; return 4264 + (n - 3840); }
        if (n < 7168) return 2312 + (n - 6912);
        if (n < 7296) return 2568 + (n - 7168);
        if (n < 7328) { const int i = n - 7296; return 2696 + ((i & 1) ? (i >> 1) + 16 : (i >> 1)); }
        if (n < 7336) return 2304 + (n - 7328);
        return -1;
    } else if (KIND == 1) {
        const int hd = n / 96, off = n - hd * 96; sc = QS96;
        if (off < 64) return n;
        const int i = off - 64; return hd * 96 + 64 + ((i & 1) ? (i >> 1) + 16 : (i >> 1));
    }
    return n;
}
template <int KIND> __device__ __forceinline__ void transpose_item(const float* W, int K, int Ns, bf16_t* WT, int item, int nblk, const float* ksc, LAS float* scr, int lane) {
    const int kb = item / nblk, nb = item - kb * nblk, k0 = 64 * kb, n0 = 32 * nb;
    float csc; const int sc_ = src_col<KIND>(n0 + (lane & 31), csc);
    const bool plain = KIND == 0 ? (n0 < 7296) : KIND == 1 ? ((n0 % 96) < 64) : true;
    if (plain) {
        float c0; const int s0 = src_col<KIND>(n0, c0);
        const int n4 = lane & 7, kr = lane >> 3;
        f32x4 v[8];
#pragma unroll
        for (int i = 0; i < 8; ++i) v[i] = *(const f32x4*)(W + (size_t)(k0 + 8 * i + kr) * Ns + s0 + 4 * n4);
#pragma unroll
        for (int i = 0; i < 8; ++i) { const int kk = 8 * i + kr; const float sc = ksc ? c0 * ksc[k0 + kk] : c0; LAS float* d = scr + kk * 33 + 4 * n4;
            d[0] = v[i][0] * sc; d[1] = v[i][1] * sc; d[2] = v[i][2] * sc; d[3] = v[i][3] * sc; }
    } else
#pragma unroll 8
    for (int i = 0; i < 32; ++i) { const int kk = 2 * i + (lane >> 5);
        float v = 0.f; if (sc_ >= 0) { v = W[(size_t)(k0 + kk) * Ns + sc_] * csc; if (ksc) v *= ksc[k0 + kk]; }
        scr[kk * 33 + (lane & 31)] = v; }
    asm volatile("s_waitcnt lgkmcnt(0)" ::: "memory");
    const int c = lane & 7;
#pragma unroll
    for (int j = 0; j < 4; ++j) { const int n = (lane >> 3) + 8 * j; const LAS float* s = scr + (8 * c) * 33 + n;
        u32x4 o; o.x = cvt_pk_bf16(s[0 * 33], s[1 * 33]); o.y = cvt_pk_bf16(s[2 * 33], s[3 * 33]); o.z = cvt_pk_bf16(s[4 * 33], s[5 * 33]); o.w = cvt_pk_bf16(s[6 * 33], s[7 * 33]);
        *(u32x4*)(WT + (size_t)(n0 + n) * K + k0 + 8 * c) = o; }
    asm volatile("s_waitcnt lgkmcnt(0)" ::: "memory");
}

#define XB_TMO      128
#define XB_XCNT(j)  (256  + 64 * (j))
#define XB_XSUB(j)  (1280 + 64 * (j))
#define XB_XGEN(j)  (2304 + 64 * (j))
#define XB_TOP      3328
#define XB_TOPGEN   3392
#define XB_SPIN_CAP (1u << 22)
__device__ __forceinline__ unsigned xb_ld(unsigned* p)              { return __hip_atomic_load(p, __ATOMIC_RELAXED, __HIP_MEMORY_SCOPE_AGENT); }
__device__ __forceinline__ unsigned xb_add(unsigned* p, unsigned v) { return __hip_atomic_fetch_add(p, v, __ATOMIC_RELAXED, __HIP_MEMORY_SCOPE_AGENT); }
#define XB_SPIN(cond, bar) do { unsigned _sp = 0; while (cond) { __builtin_amdgcn_s_sleep(1); \
    if ((++_sp & 255u) == 0u) { if (xb_ld(&(bar)[XB_TMO])) break; if (_sp > XB_SPIN_CAP) { atomicAdd(&(bar)[XB_TMO], 1u); break; } } } } while (0)
__device__ __forceinline__ void xcd_barrier_complete(unsigned* bar, unsigned x, unsigned G, unsigned& nloc, unsigned& nx) {
    unsigned sum, cnt, mine, sp = 0u;
    for (;;) {
        sum = 0u; cnt = 0u; mine = 0u;
#pragma unroll
        for (unsigned j = 0; j < 16; ++j) { const unsigned c = xb_ld(&bar[XB_XCNT(j)]); sum += c; cnt += (c > 0u) ? 1u : 0u; mine = (j == x) ? c : mine; }
        if (sum == G) break;
        __builtin_amdgcn_s_sleep(1);
        if ((++sp & 255u) == 0u) { if (xb_ld(&bar[XB_TMO])) break; if (sp > XB_SPIN_CAP) { atomicAdd(&bar[XB_TMO], 1u); break; } }
    }
    nloc = mine > 0u ? mine : 1u; nx = cnt > 0u ? cnt : 1u;
}
__device__ __forceinline__ void grid_barrier(unsigned* bar, volatile LAS unsigned* st, unsigned G, bool leader) {
    asm volatile("s_waitcnt vmcnt(0)" ::: "memory");
    __syncthreads();
    if (leader) {
        const unsigned x = (unsigned)__builtin_amdgcn_s_getreg((3 << 11) | 20) & 0xFu;
        __builtin_amdgcn_s_waitcnt(0);
        unsigned nloc = st[0], nx = st[1];
        if (nloc == 0u) { xcd_barrier_complete(bar, x, G, nloc, nx); st[0] = nloc; st[1] = nx; }
        const unsigned old = xb_add(&bar[XB_XSUB(x)], 1u);
        const unsigned gen = old / nloc;
        if (old + 1u == (gen + 1u) * nloc) {
            __builtin_amdgcn_fence(__ATOMIC_RELEASE, "agent");
            asm volatile("s_waitcnt vmcnt(0)" ::: "memory");
            const unsigned og = xb_add(&bar[XB_TOP], 1u);
            const unsigned tg = og / nx;
            if (og + 1u == (tg + 1u) * nx) xb_add(&bar[XB_TOPGEN], 1u);
            else XB_SPIN(xb_ld(&bar[XB_TOPGEN]) == tg, bar);
            __builtin_amdgcn_fence(__ATOMIC_ACQUIRE, "agent");
            xb_add(&bar[XB_XGEN(x)], 1u);
            asm volatile("s_waitcnt vmcnt(0)" ::: "memory");
        } else {
            XB_SPIN(xb_ld(&bar[XB_XGEN(x)]) == gen, bar);
            __builtin_amdgcn_fence(__ATOMIC_ACQUIRE, "agent");
            asm volatile("s_waitcnt vmcnt(0)" ::: "memory");
        }
    }
    __syncthreads();
}

struct Args { const float* in[13]; float* out; unsigned char* ws; };

__global__ void __launch_bounds__(512, 2) hybrid_fwd(Args args) {
    extern __shared__ __attribute__((aligned(16))) unsigned char lds_raw[];
    LAS unsigned char* lds = (LAS unsigned char*)lds_raw;
    cg::grid_group grid = cg::this_grid();
    grid.sync();
    const int wave = __builtin_amdgcn_readfirstlane((int)threadIdx.x >> 6);
    const int G = gridDim.x, gw = blockIdx.x * 8 + wave, NGW = G * 8;
    unsigned char* ws = args.ws;
    if (wave == 0) { const unsigned xcc_id = (unsigned)__builtin_amdgcn_s_getreg((3 << 11) | 20) & 0xFu; const int l0 = lane_id_v(); if (l0 == 0) { ((volatile LAS unsigned*)(lds + LDS_MISC + 16))[0] = 0u; ((volatile LAS unsigned*)(lds + LDS_MISC + 16))[1] = 0u;
                                                      (void)xb_add((unsigned*)(ws + WS_CTL + 8192) + XB_XCNT(xcc_id), 1u); } }
    __syncthreads();
    const float* x_in = args.in[0]; const float* meta_tok = args.in[1]; const float* norm_g = args.in[2]; const float* w_in = args.in[3]; const float* b_f = args.in[4];
    const float* sinks = args.in[5]; const float* q_norm_g = args.in[6]; const float* kv_norm_g = args.in[7]; const float* w_uq = args.in[8]; const float* w_ukv = args.in[9];
    const float* w_br = args.in[10]; const float* w_out = args.in[11]; const float* final_g = args.in[12];
    float* out = args.out;
#define GBAR() grid_barrier((unsigned*)(ws + WS_CTL + 8192), (volatile LAS unsigned*)(lds + LDS_MISC + 16), (unsigned)G, wave == 0 && lane_id_v() == 0)
#define WSB() unsigned char* wsb_ = ws; int blk = (int)blockIdx.x, Gs = G, wvl = wave; asm volatile("" : "+s"(wsb_), "+s"(blk), "+s"(Gs), "+s"(wvl)); GAS unsigned char* wsb = (GAS unsigned char*)wsb_
#define Win ((bf16_t*)(wsb + WS_WIN))
#define Wuq ((bf16_t*)(wsb + WS_WUQ))
#define Wukv ((bf16_t*)(wsb + WS_WUKV))
#define Wbr ((bf16_t*)(wsb + WS_WBR))
#define Wout ((bf16_t*)(wsb + WS_WOUT))
#define ROPE ((f32x2*)(wsb + WS_ROPE))
#define XB ((bf16_t*)(wsb + WS_XB))
#define P ((bf16_t*)(wsb + WS_P))
#define QC ((bf16_t*)(wsb + WS_QC))
#define KVC ((bf16_t*)(wsb + WS_KVC))
#define CQ ((bf16_t*)(wsb + WS_CQ))
#define YACC ((float*)(wsb + WS_YACC))
#define CKV ((bf16_t*)(wsb + WS_CKV))
#define KR ((bf16_t*)(wsb + WS_KR))
#define BFL ((float*)(wsb + WS_BFL))
#define FC ((float*)(wsb + WS_FC))
#define OZ ((bf16_t*)(wsb + WS_OZ))
#define Y ((bf16_t*)(wsb + WS_Y))
#define XM ((float*)(wsb + WS_XM))
#define SSQX ((float*)(wsb + WS_SSQX))
#define SSQQ ((float*)(wsb + WS_SSQQ))
#define SSQKV ((float*)(wsb + WS_SSQKV))

    {
        WSB();
        const int lane = lane_id_v(), tid = wave * 64 + lane;
        LAS float* scr = (LAS float*)(lds + wave * 16384);
        constexpr int I_IN = (D / 64) * (NIN / 32), I_UQ = (256 / 64) * (768 / 32), I_UKV = (128 / 64) * (1024 / 32), I_BR = 3 * (512 / 64) * (1024 / 32), I_OUT = (1024 / 64) * (1024 / 32);
        constexpr int I_L = I_IN + I_UQ + I_UKV + I_BR + I_OUT;
        for (int it = gw; it < DEPTH * I_L; it += NGW) {
            const int l = it / I_L; int r = it - l * I_L;
            if (r < I_IN) { transpose_item<0>(w_in + (size_t)l * D * DIN, D, DIN, Win + (size_t)l * NIN * D, r, NIN / 32, norm_g + l * D, scr, lane); continue; } r -= I_IN;
            if (r < I_UQ) { transpose_item<1>(w_uq + (size_t)l * 256 * 768, 256, 768, Wuq + (size_t)l * 768 * 256, r, 768 / 32, q_norm_g + l * 256, scr, lane); continue; } r -= I_UQ;
            if (r < I_UKV) { transpose_item<2>(w_ukv + (size_t)l * 128 * 1024, 128, 1024, Wukv + (size_t)l * 1024 * 128, r, 1024 / 32, kv_norm_g + l * 128, scr, lane); continue; } r -= I_UKV;
            if (r < I_BR) { const int z = r / (I_BR / 3), rr = r - z * (I_BR / 3);
                transpose_item<2>(w_br + ((size_t)l * 3 + z) * 512 * 1024, 512, 1024, Wbr + ((size_t)l * 3 + z) * 1024 * 512, rr, 1024 / 32, nullptr, scr, lane); continue; } r -= I_BR;
            transpose_item<2>(w_out + (size_t)l * 1024 * 1024, 1024, 1024, Wout + (size_t)l * 1024 * 1024, r, 1024 / 32, nullptr, scr, lane);
        }
        for (int i = blockIdx.x * 512 + tid; i < NPOS * 16; i += G * 512) {
            const int p = i >> 4, j = i & 15;
            const double inv = pow(10000.0, -(double)j / 16.0), ang = (double)p * inv;
            ROPE[i] = (f32x2){(float)cos(ang), (float)sin(ang)};
        }
    }

    for (int chunk = 0; chunk < NCHUNK; ++chunk) {
        const int Mc = chunk == 0 ? MC : MR;
        const float* x_chunk = x_in + (size_t)chunk * MR * D;
        float* out_chunk = out + (size_t)chunk * MR * D;
        { WSB(); const int lane = lane_id_v();
        for (int m = gw; m < Mc; m += 2 * NGW) {
            const int mb = (m + NGW < Mc) ? m + NGW : m;
            const float* xr = m < MR ? x_chunk + (size_t)m * D : meta_tok + (size_t)((m - MR) & (NMETA - 1)) * D;
            const float* xs = mb < MR ? x_chunk + (size_t)mb * D : meta_tok + (size_t)((mb - MR) & (NMETA - 1)) * D;
            const f32x4* xv = (const f32x4*)xr + lane; const f32x4* xw = (const f32x4*)xs + lane; f32x4 v[4], w[4]; float s = 0.f, t = 0.f;
#pragma unroll
            for (int j = 0; j < 4; ++j) { v[j] = xv[64 * j]; w[j] = xw[64 * j]; }
#pragma unroll
            for (int j = 0; j < 4; ++j) { s += (v[j][0] * v[j][0] + v[j][1] * v[j][1]) + (v[j][2] * v[j][2] + v[j][3] * v[j][3]); t += (w[j][0] * w[j][0] + w[j][1] * w[j][1]) + (w[j][2] * w[j][2] + w[j][3] * w[j][3]); }
            s = wave_sum(s, lane); t = wave_sum(t, lane);
            u32x2* o8 = (u32x2*)(XB + ((size_t)chunk * MC + m) * D) + lane; u32x2* p8 = (u32x2*)(XB + ((size_t)chunk * MC + mb) * D) + lane;
#pragma unroll
            for (int j = 0; j < 4; ++j) { u32x2 a; a.x = cvt_pk_bf16(v[j][0], v[j][1]); a.y = cvt_pk_bf16(v[j][2], v[j][3]); o8[64 * j] = a;
                                          u32x2 c; c.x = cvt_pk_bf16(w[j][0], w[j][1]); c.y = cvt_pk_bf16(w[j][2], w[j][3]); p8[64 * j] = c; }
            if (lane < 16) { SSQX[((size_t)chunk * MC + m) * 16 + lane] = lane == 0 ? s : 0.f; SSQX[((size_t)chunk * MC + mb) * 16 + lane] = lane == 0 ? t : 0.f; }
        } }
    }
    GBAR();
    for (int l = 0; l < DEPTH; ++l) {
      for (int chunk = 0; chunk < NCHUNK; ++chunk) {
        const int Mc = chunk == 0 ? MC : MR;
        const float* x_chunk = x_in + (size_t)chunk * MR * D;
        float* out_chunk = out + (size_t)chunk * MR * D;
            {
                WSB();
                pg8::Gemm g{XB + (size_t)chunk * MC * 1024, Win + (size_t)l * NIN * D, Mc, NIN, D, 0, 0};
                pg8::StaticOrder S; S.init(Mc, NIN, Gs, blk, 1);
                EpiIn E{P, CQ, CKV, KR, BFL, SSQX + (size_t)chunk * MC * 16, SSQQ, SSQKV, ROPE, lds};
                pg8::gemm_phase(lds, g, S, E, wvl);
            }
            GBAR();
            if (gw < CB * 8) {
                WSB(); const int lane = lane_id_v();
                const int b = gw >> 3, h = gw & 7; const float bf = b_f[l * 8 + h];
                const int p0 = 33 * lane;
                float lf[33];
#pragma unroll
                for (int i = 0; i < 33; ++i) { const int p = (p0 + i < NPOS) ? p0 + i : NPOS - 1; const int row = p < NMETA ? MR + b * NMETA + p : b * T + (p - NMETA);
                    lf[i] = BFL[(size_t)row * 8 + h]; }
                float tot = 0.f;
#pragma unroll
                for (int i = 0; i < 33; ++i) { const float xv = lf[i] + bf; const float v = fminf(xv, 0.f) - __logf(1.0f + __expf(-fabsf(xv))); lf[i] = (p0 + i < NPOS) ? v : 0.f; tot += lf[i]; }
                float inc = tot;
#pragma unroll
                for (int o = 1; o < 64; o <<= 1) { const float t = __int_as_float(__builtin_amdgcn_ds_bpermute(((lane - o) & 63) << 2, __float_as_int(inc))); if (lane >= o) inc += t; }
                float run = inc - tot;
#pragma unroll
                for (int i = 0; i < 33; ++i) { const int p = p0 + i; run += lf[i];
                    if (p < NPOS) { const int row = p < NMETA ? MR + b * NMETA + p : b * T + (p - NMETA); FC[(size_t)row * 8 + h] = run * LOG2E; } }
            }
            {
                WSB();
                pg8::Gemm g{CQ, Wuq + (size_t)l * 768 * 256, Mc, 768, 256, 0, 0};
                pg8::StaticOrder S; S.init(Mc, 768, Gs, blk, 1);
                EpiUp<false> E{QC, 768, SSQQ, 1.0f / 256.0f, ROPE, lds};
                pg8::gemm_phase(lds, g, S, E, wvl);
            }
            {
                WSB();
                pg8::Gemm g{CKV, Wukv + (size_t)l * 1024 * 128, Mc, 1024, 128, 0, 0};
                pg8::StaticOrder S; S.init(Mc, 1024, Gs, Gs == 256 ? ((blk + 120) & 255) : blk, 1);
                EpiUp<false> E{KVC, 1024, SSQKV, 1.0f / 128.0f, ROPE, lds};
                pg8::gemm_phase(lds, g, S, E, wvl);
            }
            GBAR();
            {
                WSB();
                AttnArgs a{P, QC, KVC, KR, FC, OZ, sinks + l * 8, ROPE};
                attn_phase(lds, a, (unsigned*)(wsb + WS_CTL) + 128 * (chunk * DEPTH + l), wvl, chunk == 0);
            }
            GBAR();
            {
                WSB();
                pg8::Gemm g{OZ, Wbr + (size_t)l * 3 * 1024 * 512, Mc, 1024, 512, (size_t)MC * 512, (size_t)1024 * 512};
                pg8::StaticOrder S; S.init(Mc, 1024, Gs, blk, 3, 128);
                EpiBr E{P, Y};
                pg8::gemm_phase<EpiBr, pg8::StaticOrder, true>(lds, g, S, E, wvl);
            }
            GBAR();
            {
                WSB();
                pg8::Gemm g{Y, Wout + (size_t)l * 1024 * 1024, Mc, 1024, 1024, 0, 0};
                pg8::StaticOrder S; S.init(Mc, 1024, Gs, blk, 1);
                EpiOut E{l == 0 ? x_chunk : out_chunk, l == 0 ? meta_tok : XM, l == 0 ? (NMETA - 1) : 0x7fffffff, out_chunk, XM, XB + (size_t)chunk * MC * 1024, SSQX + (size_t)chunk * MC * 16, l < DEPTH - 1};
                pg8::gemm_phase(lds, g, S, E, wvl);
            }
            if (l == DEPTH - 1 && chunk == NCHUNK - 1) GBAR();
      }
    }
    for (int chunk = 0; chunk < NCHUNK; ++chunk) {
        float* out_chunk = out + (size_t)chunk * MR * D;
        const int lane = lane_id_v();
        for (int m = gw; m < MR; m += 2 * NGW) {
            const int mb = (m + NGW < MR) ? m + NGW : m;
            f32x4* xv = (f32x4*)(out_chunk + (size_t)m * D) + lane; f32x4* xw = (f32x4*)(out_chunk + (size_t)mb * D) + lane; f32x4 v[4], w[4]; float s = 0.f, t = 0.f;
#pragma unroll
            for (int j = 0; j < 4; ++j) { v[j] = xv[64 * j]; w[j] = xw[64 * j]; }
#pragma unroll
            for (int j = 0; j < 4; ++j) { s += (v[j][0] * v[j][0] + v[j][1] * v[j][1]) + (v[j][2] * v[j][2] + v[j][3] * v[j][3]); t += (w[j][0] * w[j][0] + w[j][1] * w[j][1]) + (w[j][2] * w[j][2] + w[j][3] * w[j][3]); }
            s = wave_sum(s, lane); t = wave_sum(t, lane);
            const float rs = __builtin_amdgcn_rsqf(s * (1.0f / 1024.0f) + EPS), rt = __builtin_amdgcn_rsqf(t * (1.0f / 1024.0f) + EPS);
#pragma unroll
            for (int j = 0; j < 4; ++j) { const f32x4 gv = ((const f32x4*)final_g)[64 * j + lane]; xv[64 * j] = v[j] * rs * gv; if (mb != m) xw[64 * j] = w[j] * rt * gv; }
        }
    }
}

extern "C" void kernel_launch(void* const* d_in, const int* in_sizes, int n_in, void* d_out, int out_size, void* d_ws, size_t ws_size, hipStream_t stream) {
    static int grid = 0;
    if (grid == 0) {
        if (n_in != 13 || ws_size < WS_END) { fprintf(stderr, "kernel_launch: bad inputs (n_in %d, ws %zu < %zu)\n", n_in, ws_size, (size_t)WS_END); grid = -1; return; }
        int dev = 0, cus = 0, per_cu = 0;
        hipGetDevice(&dev); hipDeviceGetAttribute(&cus, hipDeviceAttributeMultiprocessorCount, dev);
        hipFuncSetAttribute((const void*)hybrid_fwd, hipFuncAttributeMaxDynamicSharedMemorySize, LDS_BYTES);
        hipOccupancyMaxActiveBlocksPerMultiprocessor(&per_cu, (const void*)hybrid_fwd, 512, LDS_BYTES);
        if (per_cu < 1) { fprintf(stderr, "kernel_launch: occupancy query says %d blocks per CU\n", per_cu); per_cu = 1; }
        (void)hipGetLastError();
        grid = cus;
    }
    if (grid < 0) return;
    hipMemsetAsync((char*)d_ws + WS_CTL, 0, CTL_BYTES, stream);
    Args a{};
    for (int i = 0; i < 13; ++i) a.in[i] = (const float*)d_in[i];
    a.out = (float*)d_out; a.ws = (unsigned char*)d_ws;
    void* kargs[] = {&a};
    hipError_t e = hipLaunchCooperativeKernel((const void*)hybrid_fwd, dim3(grid), dim3(512), kargs, LDS_BYTES, stream);
    if (e != hipSuccess) fprintf(stderr, "cooperative launch failed: %s (grid %d)\n", hipGetErrorString(e), grid);
}
```

```cpp
#include <hip/hip_runtime.h>
#include <hip/hip_cooperative_groups.h>
#include <cstdio>
#include <cstdint>
namespace cg = cooperative_groups;

#define LAS __attribute__((address_space(3)))
#define GAS __attribute__((address_space(1)))
typedef unsigned short bf16_t;
typedef short bf16x8 __attribute__((ext_vector_type(8)));
typedef short s16x4 __attribute__((ext_vector_type(4)));
typedef float f32x4 __attribute__((ext_vector_type(4)));
typedef float f32x2 __attribute__((ext_vector_type(2)));
typedef unsigned u32x4 __attribute__((ext_vector_type(4)));
typedef unsigned u32x2 __attribute__((ext_vector_type(2)));

constexpr int NBATCH = 32, T = 2048, D = 1024, DEPTH = 4, NMETA = 16;
constexpr int CB = 16, NCHUNK = NBATCH / CB;
constexpr int MR = CB * T;
constexpr int MC = MR + CB * NMETA;
constexpr int DIN = 7336, NIN = 7424, LDP = 6912;
constexpr int NPOS = NMETA + T;
constexpr float EPS = 1e-6f;
constexpr float LOG2E = 1.4426950408889634f;
constexpr float QS64 = 0.125f * LOG2E;
constexpr float QS96 = 0.10206207261596577f * LOG2E;
constexpr int PC_Z = 2304, PC_G = 3840;

constexpr size_t al256(size_t x) { return (x + 255) & ~(size_t)255; }
constexpr size_t WS_CTL = 0, CTL_BYTES = 24576;
constexpr size_t SZ_WIN = (size_t)NIN * D * 2, SZ_WUQ = (size_t)768 * 256 * 2, SZ_WUKV = (size_t)1024 * 128 * 2, SZ_WBR = (size_t)3 * 1024 * 512 * 2, SZ_WOUT = (size_t)1024 * 1024 * 2;
constexpr size_t WS_WIN = 24576;
constexpr size_t WS_WUQ = WS_WIN + DEPTH * SZ_WIN;
constexpr size_t WS_WUKV = WS_WUQ + DEPTH * SZ_WUQ;
constexpr size_t WS_WBR = WS_WUKV + DEPTH * SZ_WUKV;
constexpr size_t WS_WOUT = WS_WBR + DEPTH * SZ_WBR;
constexpr size_t WS_ROPE = WS_WOUT + DEPTH * SZ_WOUT;
constexpr size_t WS_XB = al256(WS_ROPE + (size_t)NPOS * 16 * 8);
constexpr size_t WS_P = al256(WS_XB + (size_t)NCHUNK * MC * 1024 * 2);
constexpr size_t WS_QC = al256(WS_P + (size_t)MC * LDP * 2);
constexpr size_t WS_KVC = WS_QC + (size_t)MC * 768 * 2;
constexpr size_t WS_CQ = WS_KVC + (size_t)MC * 1024 * 2;
constexpr size_t WS_YACC = WS_QC;
static_assert((size_t)MC * 1024 * 4 <= (size_t)MC * (768 + 1024 + 256) * 2, "Yacc overlay");
constexpr size_t WS_CKV = al256(WS_CQ + (size_t)MC * 256 * 2);
constexpr size_t WS_KR = al256(WS_CKV + (size_t)MC * 128 * 2);
constexpr size_t WS_BFL = al256(WS_KR + (size_t)MC * 32 * 2);
constexpr size_t WS_FC = al256(WS_BFL + (size_t)MC * 8 * 4);
constexpr size_t WS_OZ = al256(WS_FC + (size_t)MC * 8 * 4);
constexpr size_t WS_Y = al256(WS_OZ + (size_t)3 * MC * 512 * 2);
constexpr size_t WS_XM = al256(WS_Y + (size_t)MC * 1024 * 2);
constexpr size_t WS_SSQX = al256(WS_XM + (size_t)256 * 1024 * 4);
constexpr size_t WS_SSQQ = al256(WS_SSQX + (size_t)NCHUNK * MC * 16 * 4);
constexpr size_t WS_SSQKV = al256(WS_SSQQ + (size_t)MC * 4 * 4);
constexpr size_t WS_END = al256(WS_SSQKV + (size_t)MC * 4 * 4);
static_assert(WS_END <= (size_t)1 << 30, "workspace map must fit 1 GiB");

constexpr int LDS_RING = 131072, LDS_MISC = LDS_RING, LDS_RS = LDS_RING + 64, LDS_PART = LDS_RING + 2048, LDS_BYTES = LDS_RING + 2048 + 16384;

typedef __bf16 bf16x2_t __attribute__((ext_vector_type(2)));
__device__ __forceinline__ unsigned cvt_pk_bf16(float lo, float hi) { f32x2 v = {lo, hi}; bf16x2_t b = __builtin_convertvector(v, bf16x2_t); return __builtin_bit_cast(unsigned, b); }
__device__ __forceinline__ float bf2f(unsigned short h) { return __uint_as_float((unsigned)h << 16); }
__device__ __forceinline__ float bflo(unsigned w) { return __uint_as_float(w << 16); }
__device__ __forceinline__ float bfhi(unsigned w) { return __uint_as_float(w & 0xffff0000u); }
__device__ __forceinline__ int lane_id_v() { int l; asm volatile("v_mbcnt_lo_u32_b32 %0, -1, 0\n\tv_mbcnt_hi_u32_b32 %0, -1, %0" : "=v"(l)); return l; }
__device__ __forceinline__ int row_pos(int m) { return m < MR ? NMETA + (m & (T - 1)) : ((m - MR) & (NMETA - 1)); }
__device__ __forceinline__ float wave_sum(float v, int lane) {
#pragma unroll
    for (int o = 1; o < 64; o <<= 1) v += __int_as_float(__builtin_amdgcn_ds_bpermute((lane ^ o) << 2, __float_as_int(v)));
    return v;
}

namespace pg8 {
constexpr int BM = 256, BK = 64, HALF = 128, HTB = HALF * BK * 2, STAGE_BYTES = 8 * HTB, NXCD = 8, WGM = 8;
__host__ __device__ __forceinline__ int lds_byte(int r, int c) { const int st = (r >> 4) * 2 + (c >> 5), rr = r & 15, cc = c & 31, ob = rr * 64 + cc * 2; return st * 1024 + (ob ^ (((ob >> 9) & 1) << 5)); }
__host__ __device__ __forceinline__ void stage_rc(int b, int& R, int& C) { const int st = b / 1024, sb = b % 1024, swz = sb ^ (((sb >> 9) & 1) << 5); R = (st >> 1) * 16 + swz / 64; C = (st & 1) * 32 + (swz % 64) / 2; }
__host__ __device__ __forceinline__ int perm32(int rho) { const int n = rho >> 4, i = rho & 15; return 8 * (i >> 2) + 4 * n + (i & 3); }

struct Unit { int pm, pn, z; };
struct Gemm { const bf16_t* A; const bf16_t* Bt; int M, N, K; size_t zA, zB; };

struct StaticOrder {
    int nM, nN, nwg, G, c, NZ;
    __device__ void init(int M, int N, int G_, int c_, int NZ_, int BN_ = BM) { nM = M / BM; nN = N / BN_; nwg = nM * nN; G = G_; c = c_; NZ = NZ_; }
    __device__ bool next(int i, Unit& u) const {
        const int it = i / NZ; u.z = i - it * NZ;
        const long L = (long)it * G + c; if (L >= nwg) return false;
        int wgid = (int)L; { const int q = nwg / NXCD, r = nwg % NXCD, xcd = wgid % NXCD, off = wgid / NXCD; wgid = (xcd < r ? xcd * (q + 1) : r * (q + 1) + (xcd - r) * q) + off; }
        const int nig = WGM * nN, gid = wgid / nig, fm = gid * WGM, gsz = (nM - fm) < WGM ? (nM - fm) : WGM;
        u.pm = fm + ((wgid % nig) % gsz); u.pn = (wgid % nig) / gsz; return true;
    }
};

template <class Epi, class Sched, bool HALFN = false>
__device__ __forceinline__ void gemm_phase(LAS unsigned char* lds, const Gemm g, const Sched& S, const Epi& E, int wave_s) {
    const int lane = lane_id_v(), wid = wave_s, tid = wid * 64 + lane, wr = wid >> 2, wc = wid & 3, fr = lane & 15, fq = lane >> 4;
    const int K = g.K, nt = K / BK;
    unsigned voffA[2], voffB[2];
#pragma unroll
    for (int i = 0; i < 2; ++i) { int R, C; stage_rc(tid * 16 + i * 8192, R, C); const int Rb = (R & ~31) + perm32(R & 31);
        voffA[i] = (unsigned)(R * K + C) * 2u; voffB[i] = (unsigned)(Rb * K + C) * 2u; }
    const size_t kstep = (size_t)(BK * 2);
    const size_t hstep = (size_t)HALF * K * 2;
    const size_t tstep = 2 * hstep;
    const unsigned ldsw = (unsigned)wid * 1024u;
#define PG8_SA(b, h) (((b) * 2 + (h)) * HTB)
#define PG8_SB(b, h) ((4 + (b) * 2 + (h)) * HTB)
#define PG8_STAGE(bufoff, gbase, voff) do { _Pragma("unroll") for (int _i = 0; _i < 2; ++_i) \
        __builtin_amdgcn_global_load_lds((const unsigned*)((const char*)(gbase) + (voff)[_i]), (LAS unsigned*)(lds + (bufoff) + ldsw + _i * 8192), 16, 0, 0); } while (0)
#define PG8_LDA(dst, b, h) do { _Pragma("unroll") for (int m = 0; m < 4; ++m) _Pragma("unroll") for (int k = 0; k < 2; ++k) dst[m][k] = *(const LAS bf16x8*)(lds + PG8_SA(b, h) + aoff + m * 2048 + k * 1024); } while (0)
#define PG8_LDB(dst, b, h) do { _Pragma("unroll") for (int n = 0; n < 2; ++n) _Pragma("unroll") for (int k = 0; k < 2; ++k) dst[n][k] = *(const LAS bf16x8*)(lds + PG8_SB(b, h) + boff + n * 2048 + k * 1024); } while (0)
#define PG8_MMA(ai, bj, At, Bt) do { __builtin_amdgcn_s_setprio(1); _Pragma("unroll") for (int m = 0; m < 4; ++m) _Pragma("unroll") for (int n = 0; n < 2; ++n) _Pragma("unroll") for (int k = 0; k < 2; ++k) \
        acc[ai][bj][m][n] = __builtin_amdgcn_mfma_f32_16x16x32_bf16(Bt[n][k], At[m][k], acc[ai][bj][m][n], 0, 0, 0); __builtin_amdgcn_s_setprio(0); } while (0)
#define PG8_WAIT_V(n) asm volatile("s_waitcnt vmcnt(" #n ")" ::: "memory")
#define PG8_WAIT_L(n) asm volatile("s_waitcnt lgkmcnt(" #n ")" ::: "memory")
#define PG8_BAR __builtin_amdgcn_s_barrier()
#define PG8_SCHED __builtin_amdgcn_sched_barrier(0)
    Unit cur, nxt; int ui = 0;
    if (!S.next(0, cur)) return;
    if constexpr (Epi::PREFETCH) E.prefetch(cur, wid, lane);
    f32x4 acc[2][2][4][2];
#pragma unroll
    for (int a = 0; a < 2; ++a)
#pragma unroll
        for (int b = 0; b < 2; ++b)
#pragma unroll
            for (int m = 0; m < 4; ++m)
#pragma unroll
                for (int n = 0; n < 2; ++n) acc[a][b][m][n] = (f32x4){0.f, 0.f, 0.f, 0.f};
    f32x4 yacc[2][4][2]; u32x4 gpre[8];
    if constexpr (HALFN) E.gates(cur, wr, wc, lane, gpre);
    if constexpr (HALFN) {
#pragma unroll
        for (int a = 0; a < 2; ++a)
#pragma unroll
            for (int m = 0; m < 4; ++m)
#pragma unroll
                for (int n = 0; n < 2; ++n) yacc[a][m][n] = (f32x4){0.f, 0.f, 0.f, 0.f};
    }
    bf16x8 At[4][2], B0[2][2], B1[2][2];
    const char* cA = (const char*)g.A + (size_t)cur.z * g.zA * 2 + (size_t)cur.pm * tstep; const char* cB = (const char*)g.Bt + (size_t)cur.z * g.zB * 2 + (size_t)cur.pn * (HALFN ? hstep : tstep);
    const size_t bh1 = HALFN ? 0 : hstep;
    PG8_STAGE(PG8_SB(0, 0), cB, voffB); PG8_STAGE(PG8_SB(0, 1), cB + bh1, voffB); PG8_STAGE(PG8_SA(0, 0), cA, voffA); PG8_STAGE(PG8_SA(0, 1), cA + hstep, voffA);
    if (wr == 1) PG8_BAR;
    PG8_WAIT_V(2); PG8_BAR;
    PG8_STAGE(PG8_SB(1, 0), cB + kstep, voffB); PG8_STAGE(PG8_SA(1, 0), cA + kstep, voffA); PG8_STAGE(PG8_SB(1, 1), cB + bh1 + kstep, voffB);
    PG8_WAIT_V(6); PG8_BAR;
    const int l3 = lane_id_v();
    const int aoff = lds_byte(wr * 64 + (l3 & 15), (l3 >> 4) * 8), boff = lds_byte(wc * 32 + (l3 & 15), (l3 >> 4) * 8);
    for (;;) {
        const bool has_next = S.next(ui + 1, nxt);
        const char* nA = has_next ? (const char*)g.A + (size_t)nxt.z * g.zA * 2 + (size_t)nxt.pm * tstep : cA; const char* nB = has_next ? (const char*)g.Bt + (size_t)nxt.z * g.zB * 2 + (size_t)nxt.pn * (HALFN ? hstep : tstep) : cB;
        for (int t = 0; t < nt; t += 2) {
            const bool last = (t == nt - 2);
            const char* a1 = cA + (size_t)(t + 1) * kstep;
            const char* a2 = last ? nA : cA + (size_t)(t + 2) * kstep; const char* b2 = last ? nB : cB + (size_t)(t + 2) * kstep;
            const char* a3 = a2 + kstep; const char* b3 = b2 + kstep;
            PG8_LDB(B0, 0, 0); if (!HALFN) PG8_LDB(B1, 0, 1); PG8_SCHED; PG8_LDA(At, 0, 0); PG8_STAGE(PG8_SA(1, 1), a1 + hstep, voffA);
            PG8_WAIT_V(8); PG8_WAIT_L(0); PG8_BAR; PG8_MMA(0, 0, At, B0); if (!HALFN) PG8_MMA(0, 1, At, B1); PG8_BAR; PG8_SCHED;
            PG8_LDA(At, 0, 1); PG8_STAGE(PG8_SB(0, 0), b2, voffB); PG8_STAGE(PG8_SB(0, 1), b2 + bh1, voffB); PG8_STAGE(PG8_SA(0, 0), a2, voffA);
            PG8_WAIT_V(8); PG8_WAIT_L(0); PG8_BAR; PG8_MMA(1, 0, At, B0); if (!HALFN) PG8_MMA(1, 1, At, B1); PG8_BAR; PG8_SCHED;
            PG8_LDB(B0, 1, 0); if (!HALFN) PG8_LDB(B1, 1, 1); PG8_SCHED; PG8_LDA(At, 1, 0); PG8_STAGE(PG8_SA(0, 1), a2 + hstep, voffA);
            PG8_WAIT_V(8); PG8_WAIT_L(0); PG8_BAR; PG8_MMA(0, 0, At, B0); if (!HALFN) PG8_MMA(0, 1, At, B1); PG8_BAR; PG8_SCHED;
            PG8_LDA(At, 1, 1); PG8_STAGE(PG8_SB(1, 0), b3, voffB); PG8_STAGE(PG8_SB(1, 1), b3 + bh1, voffB); PG8_STAGE(PG8_SA(1, 0), a3, voffA);
            PG8_WAIT_V(8); PG8_WAIT_L(0); PG8_BAR; PG8_MMA(1, 0, At, B0); if (!HALFN) PG8_MMA(1, 1, At, B1); PG8_BAR; PG8_SCHED;
        }
        if (wr == 0) PG8_BAR;
        { const int l2 = lane_id_v(), fr2 = l2 & 15, fq2 = l2 >> 4;
          if constexpr (HALFN) E.accum(acc, yacc, gpre, cur, wr, wc, fr2, fq2); else E(acc, cur, wr, wc, fr2, fq2); }
        if (!has_next) break;
#pragma unroll
        for (int a = 0; a < 2; ++a)
#pragma unroll
            for (int b = 0; b < 2; ++b)
#pragma unroll
                for (int m = 0; m < 4; ++m)
#pragma unroll
                    for (int n = 0; n < 2; ++n) acc[a][b][m][n] = (f32x4){0.f, 0.f, 0.f, 0.f};
        cur = nxt; cA = nA; cB = nB; ++ui;
        if constexpr (Epi::PREFETCH) E.prefetch(cur, wid, lane_id_v());
        if constexpr (HALFN) E.gates(cur, wr, wc, lane_id_v(), gpre);
        if (wr == 1) PG8_BAR;
    }
    PG8_WAIT_V(0);
    PG8_BAR;
#undef PG8_SA
#undef PG8_SB
#undef PG8_STAGE
#undef PG8_LDA
#undef PG8_LDB
#undef PG8_MMA
#undef PG8_WAIT_V
#undef PG8_WAIT_L
#undef PG8_BAR
#undef PG8_SCHED
}
}
using pg8::Unit;

__device__ __forceinline__ u32x4 pack8(const f32x4& v0, const f32x4& v1) { u32x4 w; w.x = cvt_pk_bf16(v0[0], v0[1]); w.y = cvt_pk_bf16(v0[2], v0[3]); w.z = cvt_pk_bf16(v1[0], v1[1]); w.w = cvt_pk_bf16(v1[2], v1[3]); return w; }
__device__ __forceinline__ float sumsq8(const f32x4& a, const f32x4& b) { return (a[0] * a[0] + a[1] * a[1]) + (a[2] * a[2] + a[3] * a[3]) + (b[0] * b[0] + b[1] * b[1]) + (b[2] * b[2] + b[3] * b[3]); }
__device__ __forceinline__ float max3f(float a, float b, float c) { return __builtin_fmaxf(__builtin_fmaxf(a, b), c); }
__device__ __forceinline__ float quad_max(float v) {
    auto a = __builtin_amdgcn_permlane16_swap(__float_as_uint(v), __float_as_uint(v), false, false);
    v = fmaxf(__uint_as_float(a[0]), __uint_as_float(a[1]));
    auto c = __builtin_amdgcn_permlane32_swap(__float_as_uint(v), __float_as_uint(v), false, false);
    return fmaxf(__uint_as_float(c[0]), __uint_as_float(c[1]));
}
__device__ __forceinline__ float quad_sum(float v) {
    auto a = __builtin_amdgcn_permlane16_swap(__float_as_uint(v), __float_as_uint(v), false, false);
    v = __uint_as_float(a[0]) + __uint_as_float(a[1]);
    auto c = __builtin_amdgcn_permlane32_swap(__float_as_uint(v), __float_as_uint(v), false, false);
    return __uint_as_float(c[0]) + __uint_as_float(c[1]);
}
__device__ __forceinline__ void rope8(f32x4& v0, f32x4& v1, const f32x2* rope, int p, int i0) {
    const f32x2* rp = rope + p * 16 + i0;
    const f32x2 c0 = rp[0], c1 = rp[1], c2 = rp[2], c3 = rp[3];
    f32x4 o0, o1;
    o0[0] = v0[0] * c0.x - v0[1] * c0.y; o0[1] = v0[1] * c0.x + v0[0] * c0.y;
    o0[2] = v0[2] * c1.x - v0[3] * c1.y; o0[3] = v0[3] * c1.x + v0[2] * c1.y;
    o1[0] = v1[0] * c2.x - v1[1] * c2.y; o1[1] = v1[1] * c2.x + v1[0] * c2.y;
    o1[2] = v1[2] * c3.x - v1[3] * c3.y; o1[3] = v1[3] * c3.x + v1[2] * c3.y;
    v0 = o0; v1 = o1;
}

template <int NP> __device__ __forceinline__ void unit_prefetch(LAS unsigned char* lds, const float* SSQ, int pm, int wid, int lane) {
    const int tid = wid * 64 + lane;
    if (NP == 16) {
        const float* src = SSQ + (size_t)(pm * 256 + (tid >> 1)) * 16 + (tid & 1) * 8;
        __builtin_amdgcn_global_load_lds((const unsigned*)src, (LAS unsigned*)(lds + LDS_PART + wid * 1024), 16, 0, 0);
        __builtin_amdgcn_global_load_lds((const unsigned*)(src + 4), (LAS unsigned*)(lds + LDS_PART + 8192 + wid * 1024), 16, 0, 0);
    } else {
        if (wid < 4) __builtin_amdgcn_global_load_lds((const unsigned*)(SSQ + (size_t)(pm * 256 + tid) * 4), (LAS unsigned*)(lds + LDS_PART + wid * 1024), 16, 0, 0);
    }
}
template <int NP> __device__ __forceinline__ void unit_rstd(LAS unsigned char* lds, float inv_n, int tid_in) {
    int tid = tid_in; asm volatile("" : "+v"(tid));
    LAS float* rs = (LAS float*)(lds + LDS_RS);
    if (NP == 16) {
        const f32x4 a = *(const LAS f32x4*)(lds + LDS_PART + tid * 16), b = *(const LAS f32x4*)(lds + LDS_PART + 8192 + tid * 16);
        float ss = ((a[0] + a[1]) + (a[2] + a[3])) + ((b[0] + b[1]) + (b[2] + b[3]));
        ss += __builtin_bit_cast(float, __builtin_amdgcn_update_dpp(0, __builtin_bit_cast(int, ss), 0xB1, 0xF, 0xF, true));
        if ((tid & 1) == 0) rs[tid >> 1] = __builtin_amdgcn_rsqf(ss * inv_n + EPS);
    } else {
        if (tid < 256) { const f32x4 a = *(const LAS f32x4*)(lds + LDS_PART + tid * 16); rs[tid] = __builtin_amdgcn_rsqf(((a[0] + a[1]) + (a[2] + a[3])) * inv_n + EPS); }
    }
    asm volatile("s_waitcnt lgkmcnt(0)" ::: "memory"); __builtin_amdgcn_s_barrier(); asm volatile("" ::: "memory");
}
struct EpiIn {
    bf16_t* P; bf16_t* CQ; bf16_t* CKV; bf16_t* KR; float* BFL; const float* SSQX; float* SSQQ; float* SSQKV; const f32x2* ROPE; LAS unsigned char* lds;
    static constexpr bool PREFETCH = true;
    __device__ __forceinline__ void prefetch(const Unit& u, int wid, int lane) const { unit_prefetch<16>(lds, SSQX, u.pm, wid, lane); }
    __device__ __forceinline__ void operator()(const f32x4 (&acc)[2][2][4][2], const Unit& u, int wr, int wc, int fr, int fq) const {
        const int row0 = u.pm * 256 + wr * 64 + fr, cw = wc * 32 + 8 * fq;
        unit_rstd<16>(lds, 1.0f / 1024.0f, (wr * 4 + wc) * 64 + fq * 16 + fr);
        const LAS float* rs = (const LAS float*)(lds + LDS_RS);
#pragma unroll
        for (int ai = 0; ai < 2; ++ai)
#pragma unroll
            for (int m = 0; m < 4; ++m) {
                int row_ = row0 + ai * 128 + m * 16; asm volatile("" : "+v"(row_)); const int row = row_;
                const float rstd = rs[wr * 64 + ai * 128 + m * 16 + fr];
                f32x4 v[2][2];
#pragma unroll
                for (int bj = 0; bj < 2; ++bj) { v[bj][0] = acc[ai][bj][m][0] * rstd; v[bj][1] = acc[ai][bj][m][1] * rstd; }
                if (u.pn < 27) {
                    bf16_t* dst = P + (size_t)row * LDP + u.pn * 256 + cw;
                    *(u32x4*)(dst) = pack8(v[0][0], v[0][1]); *(u32x4*)(dst + 128) = pack8(v[1][0], v[1][1]);
                } else if (u.pn == 27) {
                    bf16_t* dst = CQ + (size_t)row * 256 + cw;
                    *(u32x4*)(dst) = pack8(v[0][0], v[0][1]); *(u32x4*)(dst + 128) = pack8(v[1][0], v[1][1]);
                    const float s = quad_sum(sumsq8(v[0][0], v[0][1]) + sumsq8(v[1][0], v[1][1]));
                    if (fq == 0) SSQQ[(size_t)row * 4 + wc] = s;
                } else {
                    *(u32x4*)(CKV + (size_t)row * 128 + cw) = pack8(v[0][0], v[0][1]);
                    const float s = quad_sum(sumsq8(v[0][0], v[0][1]));
                    if (fq == 0) SSQKV[(size_t)row * 4 + wc] = s;
                    if (wc == 0) { rope8(v[1][0], v[1][1], ROPE, row_pos(row), 4 * fq); *(u32x4*)(KR + (size_t)row * 32 + 8 * fq) = pack8(v[1][0], v[1][1]); }
                    if (wc == 1 && fq == 0) { f32x4* bp = (f32x4*)(BFL + (size_t)row * 8); bp[0] = v[1][0]; bp[1] = v[1][1]; }
                }
                }
    }
};
template <bool QROPE> struct EpiUp {
    bf16_t* O; int ldo; const float* SSQ; float inv_nk; const f32x2* ROPE; LAS unsigned char* lds;
    static constexpr bool PREFETCH = true;
    __device__ __forceinline__ void prefetch(const Unit& u, int wid, int lane) const { unit_prefetch<4>(lds, SSQ, u.pm, wid, lane); }
    __device__ __forceinline__ void operator()(const f32x4 (&acc)[2][2][4][2], const Unit& u, int wr, int wc, int fr, int fq) const {
        const int row0 = u.pm * 256 + wr * 64 + fr, col0 = u.pn * 256 + wc * 32 + 8 * fq;
        unit_rstd<4>(lds, inv_nk, (wr * 4 + wc) * 64 + fq * 16 + fr);
        const LAS float* rs = (const LAS float*)(lds + LDS_RS);
#pragma unroll
        for (int ai = 0; ai < 2; ++ai)
#pragma unroll
            for (int m = 0; m < 4; ++m) {
                int row_ = row0 + ai * 128 + m * 16; asm volatile("" : "+v"(row_)); const int row = row_;
                const float rstd = rs[wr * 64 + ai * 128 + m * 16 + fr];
#pragma unroll
                for (int bj = 0; bj < 2; ++bj) {
                    f32x4 v0 = acc[ai][bj][m][0] * rstd, v1 = acc[ai][bj][m][1] * rstd;
                    const int col = col0 + bj * 128;
                    if (QROPE) { const int off = col % 96; if (off >= 64) rope8(v0, v1, ROPE, row_pos(row), (off - 64) >> 1); }
                    *(u32x4*)(O + (size_t)row * ldo + col) = pack8(v0, v1);
                }
                }
    }
};
struct EpiBr {        static constexpr bool PREFETCH = false;
    const bf16_t* P; bf16_t* Y;
    __device__ __forceinline__ void gates(const Unit& u, int wr, int wc, int lane, u32x4 (&gp)[8]) const {
        const int fr = lane & 15, fq = lane >> 4;
        const bf16_t* gb = P + (size_t)(u.pm * 256 + wr * 64 + fr) * LDP + PC_G + u.z * 1024 + u.pn * 128 + wc * 32 + 8 * fq;
#pragma unroll
        for (int ai = 0; ai < 2; ++ai)
#pragma unroll
            for (int m = 0; m < 4; ++m) gp[ai * 4 + m] = *(const u32x4*)(gb + (size_t)(ai * 128 + m * 16) * LDP);
    }
    __device__ __forceinline__ void accum(const f32x4 (&acc)[2][2][4][2], f32x4 (&yacc)[2][4][2], const u32x4 (&gp)[8], const Unit& u, int wr, int wc, int fr, int fq) const {
        const int row0 = u.pm * 256 + wr * 64 + fr, col = u.pn * 128 + wc * 32 + 8 * fq;
#pragma unroll
        for (int ai = 0; ai < 2; ++ai)
#pragma unroll
            for (int m = 0; m < 4; ++m) {
                const int row = row0 + ai * 128 + m * 16;
                const u32x4 gw = gp[ai * 4 + m];
                f32x4 g0 = {bflo(gw.x), bfhi(gw.x), bflo(gw.y), bfhi(gw.y)}, g1 = {bflo(gw.z), bfhi(gw.z), bflo(gw.w), bfhi(gw.w)};
#pragma unroll
                for (int e = 0; e < 4; ++e) { g0[e] = __builtin_amdgcn_rcpf(1.0f + __expf(-g0[e])); g1[e] = __builtin_amdgcn_rcpf(1.0f + __expf(-g1[e]));        }
                const f32x4 y0 = g0 * acc[ai][0][m][0], y1 = g1 * acc[ai][0][m][1];
                if (u.z == 0) { yacc[ai][m][0] = y0; yacc[ai][m][1] = y1; } else { yacc[ai][m][0] += y0; yacc[ai][m][1] += y1; }
                if (u.z == 2) *(u32x4*)(Y + (size_t)row * 1024 + col) = pack8(yacc[ai][m][0], yacc[ai][m][1]);
            }
    }
};
struct EpiOut {       static constexpr bool PREFETCH = false;
    const float* res_real; const float* res_meta; int meta_mask; float* out_real; float* XM; bf16_t* XB; float* SSQX; bool feed_next;
    __device__ __forceinline__ const float* rsrc(int row) const { return row < MR ? res_real + (size_t)row * 1024 : res_meta + (size_t)((row - MR) & meta_mask) * 1024; }
    __device__ __forceinline__ void operator()(const f32x4 (&acc)[2][2][4][2], const Unit& u, int wr, int wc, int fr, int fq) const {
        const int row0 = u.pm * 256 + wr * 64 + fr, col0 = u.pn * 256 + wc * 32 + 8 * fq;
        f32x4 nx[4];
        { int r_ = row0; asm volatile("" : "+v"(r_)); const float* rs = rsrc(r_) + col0; nx[0] = *(const f32x4*)(rs); nx[1] = *(const f32x4*)(rs + 4); nx[2] = *(const f32x4*)(rs + 128); nx[3] = *(const f32x4*)(rs + 132); }
#pragma unroll
        for (int ai = 0; ai < 2; ++ai)
#pragma unroll
            for (int m = 0; m < 4; ++m) {
                int row_ = row0 + ai * 128 + m * 16; asm volatile("" : "+v"(row_)); const int row = row_;
                f32x4 cu[4] = {nx[0], nx[1], nx[2], nx[3]};
                if (ai * 4 + m < 7) { const int it = ai * 4 + m + 1; int r_ = row0 + (it >> 2) * 128 + (it & 3) * 16; asm volatile("" : "+v"(r_)); const float* rs = rsrc(r_) + col0;
                    nx[0] = *(const f32x4*)(rs); nx[1] = *(const f32x4*)(rs + 4); nx[2] = *(const f32x4*)(rs + 128); nx[3] = *(const f32x4*)(rs + 132); }
                float* rd = row < MR ? out_real + (size_t)row * 1024 : XM + (size_t)(row - MR) * 1024;
                float s = 0.f;
#pragma unroll
                for (int bj = 0; bj < 2; ++bj) {
                    const int col = col0 + bj * 128;
                    const f32x4 x0 = cu[2 * bj] + acc[ai][bj][m][0], x1 = cu[2 * bj + 1] + acc[ai][bj][m][1];
                    *(f32x4*)(rd + col) = x0; *(f32x4*)(rd + col + 4) = x1;
                    if (feed_next) { *(u32x4*)(XB + (size_t)row * 1024 + col) = pack8(x0, x1); s += sumsq8(x0, x1); }
                }
                if (feed_next) { s = quad_sum(s); if (fq == 0) SSQX[(size_t)row * 16 + u.pn * 4 + wc] = s; }
                asm volatile("" ::: "memory");
            }
    }
};

struct AttnArgs { const bf16_t* P; const bf16_t* QC; const bf16_t* KVC; const bf16_t* KR; const float* FC; bf16_t* OZ; const float* sinks; const f32x2* ROPE; };
__device__ __forceinline__ int e2row(int b, int e) { return e >= 64 ? b * T + (e - 64) : (MR + b * NMETA + (e >= 48 ? e - 48 : 0)); }

typedef short v4i16_t __attribute__((ext_vector_type(4)));
template <int TY> __device__ __forceinline__ void attn_unit(LAS unsigned char* lds, const AttnArgs& a, int b, int h, int qt, int wave_s) {
    constexpr int DK = TY == 2 ? 96 : 64, NDS = DK / 32, VSTR = 80;
    constexpr int KBYTES = 64 * DK * 2, VBYTES = 64 * VSTR * 2, BUFB = KBYTES + VBYTES + 256;
    const int lane = lane_id_v(), wv = wave_s, tid = wv * 64 + lane, fr = lane & 15, fq = lane >> 4;
    const bool meta = qt < 0;
    const int eq0 = meta ? 48 : 64 + 256 * qt;
    const int J1 = meta ? 0 : 4 * qt + 4;
    const int J0 = (TY == 0 && !meta && qt > 0) ? 4 * qt - 1 : 0;
    const bf16_t *Qp, *Kp, *Vp; int qpitch, kpitch;
    if (TY == 0) { Qp = a.P + h * 64; Kp = a.P + 512 + (h >> 2) * 64; Vp = a.P + 640 + (h >> 2) * 64; qpitch = LDP; kpitch = LDP; }
    else if (TY == 1) { Qp = a.P + 768 + h * 64; Kp = a.P + 1280 + h * 64; Vp = a.P + 1792 + h * 64; qpitch = LDP; kpitch = LDP; }
    else { Qp = a.QC + h * 96; Kp = a.KVC + h * 128; Vp = a.KVC + h * 128 + 64; qpitch = 768; kpitch = 1024; }
    bf16x8 qf[2][NDS]; int eq[2];
#pragma unroll
    for (int qb = 0; qb < 2; ++qb) {
        eq[qb] = eq0 + 32 * wv + 16 * qb + fr;
        const int qrow = e2row(b, eq[qb]);
#pragma unroll
        for (int ds = 0; ds < NDS; ++ds) qf[qb][ds] = *(const bf16x8*)(Qp + (size_t)qrow * qpitch + ds * 32 + fq * 8);
        if (TY == 2) {
            const u32x4 w = __builtin_bit_cast(u32x4, qf[qb][NDS - 1]);
            f32x4 v0 = {bflo(w.x), bfhi(w.x), bflo(w.y), bfhi(w.y)}, v1 = {bflo(w.z), bfhi(w.z), bflo(w.w), bfhi(w.w)};
            rope8(v0, v1, a.ROPE, eq[qb] - 48, 4 * fq);
            qf[qb][NDS - 1] = __builtin_bit_cast(bf16x8, pack8(v0, v1));
        }
    }
    u32x2 zpre[2][4];
#pragma unroll
    for (int qb = 0; qb < 2; ++qb) {
        const bf16_t* zp = a.P + (size_t)e2row(b, eq[qb]) * LDP + PC_Z + TY * 512 + h * 64 + 4 * fq;
#pragma unroll
        for (int db = 0; db < 4; ++db) zpre[qb][db] = *(const u32x2*)(zp + 16 * db);
    }
    const float slope2 = TY == 0 ? exp2f(-(float)(h + 1)) * LOG2E : 0.f;
    constexpr float THR = 32.0f;
    float mrun[2]; f32x4 lacc[2]; f32x4 o[2][4];
    unsigned ow_ = 0x3f803f80u; asm volatile("" : "+v"(ow_));
    const u32x4 ones_w = {ow_, ow_, ow_, ow_}; const bf16x8 ones = __builtin_bit_cast(bf16x8, ones_w);
#pragma unroll
    for (int qb = 0; qb < 2; ++qb) {
        mrun[qb] = TY == 0 ? a.sinks[h] * LOG2E : 0.f; { const float l0 = TY == 0 ? 1.f : 0.f; lacc[qb] = (f32x4){l0, l0, l0, l0}; }
#pragma unroll
        for (int db = 0; db < 4; ++db) o[qb][db] = (f32x4){0.f, 0.f, 0.f, 0.f};
    }
    const int ki = tid >> 3, kc = tid & 7, ki2 = tid >> 2, kc2 = tid & 3;
    const int kwoff = ((ki >> 4) * NDS + (kc >> 2)) * 1024 + ((((ki & 15) * 64) + (kc & 3) * 16) ^ (((ki & 15) >> 3) << 5));
    const int kwoff2 = (((ki2 & 63) >> 4) * NDS + (NDS - 1)) * 1024 + ((((ki2 & 15) * 64) + kc2 * 16) ^ (((ki2 & 15) >> 3) << 5));
    u32x4 kregA, vregA, kreg2A = {0u, 0u, 0u, 0u}; float fregA = 0.f;
    u32x4 kregB = {0u, 0u, 0u, 0u}, vregB = {0u, 0u, 0u, 0u}, kreg2B = {0u, 0u, 0u, 0u}; float fregB = 0.f;
#define ATT_LOAD(S, J) do { const int r_ = e2row(b, 64 * (J) + ki); kreg##S = *(const u32x4*)(Kp + (size_t)r_ * kpitch + kc * 8); vreg##S = *(const u32x4*)(Vp + (size_t)r_ * kpitch + kc * 8); \
        if (TY == 2) { const int r2_ = e2row(b, 64 * (J) + (ki2 & 63)); kreg2##S = *(const u32x4*)(a.KR + (size_t)r2_ * 32 + kc2 * 8); } \
        if (TY == 1) { const int r3_ = e2row(b, 64 * (J) + (tid & 63)); freg##S = a.FC[(size_t)r3_ * 8 + h]; } } while (0)
#define ATT_STORE(S, buf) do { LAS unsigned char* sb_ = lds + (buf) * BUFB; \
        *(LAS u32x4*)(sb_ + kwoff) = kreg##S; \
        if (TY == 2 && tid < 256) *(LAS u32x4*)(sb_ + kwoff2) = kreg2##S; \
        *(LAS u32x4*)(sb_ + KBYTES + (ki * VSTR + kc * 8) * 2) = vreg##S; \
        if (TY == 1 && tid < 64) *(LAS float*)(sb_ + KBYTES + VBYTES + tid * 4) = freg##S; } while (0)
    ATT_LOAD(A, J0);
    ATT_STORE(A, 0);
    ATT_LOAD(B, J0 < J1 ? J0 + 1 : J1);
    __syncthreads();
    const int koff = (fr * 64 + fq * 16) ^ ((fr >> 3) << 5);
    const int voff = KBYTES + ((4 * fq + (fr >> 2)) * VSTR + 4 * (fr & 3)) * 2;
    const int ewlo = eq0 + 32 * wv, ewhi = ewlo + 31;
    for (int Jp = J0; Jp <= J1; Jp += 2) {
#pragma unroll
      for (int hf = 0; hf < 2; ++hf) {
        const int J = Jp + hf;
        if (J > J1) break;
        const int cur = hf;
        LAS unsigned char* sb = lds + cur * BUFB;
        { const int Jn = J + 2 <= J1 ? J + 2 : J1; if (hf == 0) ATT_LOAD(A, Jn); else ATT_LOAD(B, Jn); }
        const bool skip = (64 * J > ewhi) || (TY == 0 && 64 * J + 63 + 127 < ewlo);
        if (!skip) {
        int lim[2]; f32x4 cinit[2];
#pragma unroll
        for (int qb = 0; qb < 2; ++qb) {
            lim[qb] = eq[qb] - 64 * J - 4 * fq;
            const float c0 = TY == 0 ? -(mrun[qb] + slope2 * (float)lim[qb]) : -mrun[qb];
            cinit[qb] = (f32x4){c0, c0, c0, c0};
        }
        f32x4 s[2][4];
        bf16x8 kfr[4][NDS];
#pragma unroll
        for (int kb = 0; kb < 4; ++kb)
#pragma unroll
            for (int ds = 0; ds < NDS; ++ds) kfr[kb][ds] = *(const LAS bf16x8*)(sb + koff + (kb * NDS + ds) * 1024);
#pragma unroll
        for (int kb = 0; kb < 4; ++kb) {
#pragma unroll
            for (int ds = 0; ds < NDS; ++ds) {
                s[0][kb] = __builtin_amdgcn_mfma_f32_16x16x32_bf16(kfr[kb][ds], qf[0][ds], ds == 0 ? cinit[0] : s[0][kb], 0, 0, 0);
                s[1][kb] = __builtin_amdgcn_mfma_f32_16x16x32_bf16(kfr[kb][ds], qf[1][ds], ds == 0 ? cinit[1] : s[1][kb], 0, 0, 0);
            }
        }
        bf16x8 vf[4][2];
#pragma unroll
        for (int db = 0; db < 4; ++db)
#pragma unroll
            for (int G = 0; G < 2; ++G) {
                LAS unsigned char* vp = sb + voff + (32 * G * VSTR + 16 * db) * 2;
                const v4i16_t lo = __builtin_amdgcn_ds_read_tr16_b64_v4i16((LAS v4i16_t*)vp), hi = __builtin_amdgcn_ds_read_tr16_b64_v4i16((LAS v4i16_t*)(vp + 16 * VSTR * 2));
                vf[db][G] = (bf16x8){lo[0], lo[1], lo[2], lo[3], hi[0], hi[1], hi[2], hi[3]};
            }
        if (TY == 1) {
#pragma unroll
            for (int kb = 0; kb < 4; ++kb) {
                const f32x4 fk = *(const LAS f32x4*)(sb + KBYTES + VBYTES + (16 * kb + 4 * fq) * 4);
                s[0][kb] -= fk; s[1][kb] -= fk;
            }
        }
        if (TY == 0) {
#pragma unroll
            for (int kb = 0; kb < 4; ++kb)
#pragma unroll
                for (int r = 0; r < 4; ++r)
#pragma unroll
                    for (int qb = 0; qb < 2; ++qb) {
                        const float v = s[qb][kb][r] + slope2 * (float)(16 * kb + r);
                        s[qb][kb][r] = ((unsigned)(lim[qb] - (16 * kb + r)) < 128u) ? v : -1e30f;
                    }
        } else if (64 * J + 63 > ewlo) {
#pragma unroll
            for (int kb = 0; kb < 4; ++kb)
#pragma unroll
                for (int r = 0; r < 4; ++r)
#pragma unroll
                    for (int qb = 0; qb < 2; ++qb) s[qb][kb][r] = ((16 * kb + r) <= lim[qb]) ? s[qb][kb][r] : -1e30f;
        }
        if (J == 0) {
#pragma unroll
            for (int kb = 0; kb < 3; ++kb)
#pragma unroll
                for (int qb = 0; qb < 2; ++qb) s[qb][kb] = (f32x4){-1e30f, -1e30f, -1e30f, -1e30f};
        }
        bf16x8 pf[2][2];
        float mxl[2];
#pragma unroll
        for (int qb = 0; qb < 2; ++qb) {
            float mx = max3f(s[qb][0][0], s[qb][0][1], s[qb][0][2]);
            mx = max3f(mx, s[qb][0][3], s[qb][1][0]); mx = max3f(mx, s[qb][1][1], s[qb][1][2]); mx = max3f(mx, s[qb][1][3], s[qb][2][0]);
            mx = max3f(mx, s[qb][2][1], s[qb][2][2]); mx = max3f(mx, s[qb][2][3], s[qb][3][0]); mx = max3f(mx, s[qb][3][1], s[qb][3][2]); mxl[qb] = fmaxf(mx, s[qb][3][3]);
        }
        if (__any(fmaxf(mxl[0], mxl[1]) > THR)) {
#pragma unroll
            for (int qb = 0; qb < 2; ++qb) {
                const float dl = fmaxf(quad_max(mxl[qb]), 0.f);
                mrun[qb] += dl;
                const float al = __builtin_amdgcn_exp2f(-dl);
                lacc[qb] *= al;
#pragma unroll
                for (int db = 0; db < 4; ++db) o[qb][db] *= al;
#pragma unroll
                for (int kb = 0; kb < 4; ++kb) s[qb][kb] -= dl;
            }
        }
#pragma unroll
        for (int qb = 0; qb < 2; ++qb) {
#pragma unroll
            for (int kb = 0; kb < 4; ++kb)
#pragma unroll
                for (int r = 0; r < 4; ++r) s[qb][kb][r] = __builtin_amdgcn_exp2f(s[qb][kb][r]);
#pragma unroll
            for (int G = 0; G < 2; ++G) {
                u32x4 w; w.x = cvt_pk_bf16(s[qb][2 * G][0], s[qb][2 * G][1]); w.y = cvt_pk_bf16(s[qb][2 * G][2], s[qb][2 * G][3]);
                w.z = cvt_pk_bf16(s[qb][2 * G + 1][0], s[qb][2 * G + 1][1]); w.w = cvt_pk_bf16(s[qb][2 * G + 1][2], s[qb][2 * G + 1][3]);
                pf[qb][G] = __builtin_bit_cast(bf16x8, w);
            }
        }
#pragma unroll
        for (int G = 0; G < 2; ++G) {
            lacc[0] = __builtin_amdgcn_mfma_f32_16x16x32_bf16(ones, pf[0][G], lacc[0], 0, 0, 0);
            lacc[1] = __builtin_amdgcn_mfma_f32_16x16x32_bf16(ones, pf[1][G], lacc[1], 0, 0, 0);
        }
#pragma unroll
        for (int db = 0; db < 4; ++db)
#pragma unroll
            for (int G = 0; G < 2; ++G) {
                o[0][db] = __builtin_amdgcn_mfma_f32_16x16x32_bf16(vf[db][G], pf[0][G], o[0][db], 0, 0, 0);
                o[1][db] = __builtin_amdgcn_mfma_f32_16x16x32_bf16(vf[db][G], pf[1][G], o[1][db], 0, 0, 0);
            }
        }
        if (J < J1) { if (hf == 0) ATT_STORE(B, 1); else ATT_STORE(A, 0); }
        __syncthreads();
      }
    }
#undef ATT_LOAD
#undef ATT_STORE
#pragma unroll
    for (int qb = 0; qb < 2; ++qb) {
        const float inv = __builtin_amdgcn_rcpf(lacc[qb][0]);
        const bool st = !meta || (32 * wv + 16 * qb + fr) < NMETA;
        if (st) {
            const int qrow = e2row(b, eq[qb]);
            bf16_t* op = a.OZ + (size_t)TY * MC * 512 + (size_t)qrow * 512 + h * 64 + 4 * fq;
#pragma unroll
            for (int db = 0; db < 4; ++db) {
                const u32x2 zw = zpre[qb][db];
                const float z0 = bflo(zw.x), z1 = bfhi(zw.x), z2 = bflo(zw.y), z3 = bfhi(zw.y);
                const float r0 = o[qb][db][0] * inv * (z0 * __builtin_amdgcn_rcpf(1.0f + __expf(-z0))), r1 = o[qb][db][1] * inv * (z1 * __builtin_amdgcn_rcpf(1.0f + __expf(-z1)));
                const float r2 = o[qb][db][2] * inv * (z2 * __builtin_amdgcn_rcpf(1.0f + __expf(-z2))), r3 = o[qb][db][3] * inv * (z3 * __builtin_amdgcn_rcpf(1.0f + __expf(-z3)));
                u32x2 w; w.x = cvt_pk_bf16(r0, r1); w.y = cvt_pk_bf16(r2, r3);
                *(u32x2*)(op + 16 * db) = w;
            }
        }
    }
}

constexpr int ATT_GRP = 108, ATT_QUEUE = 4 * ATT_GRP;
__device__ __forceinline__ void attn_phase(LAS unsigned char* lds, const AttnArgs& a, unsigned* ctr, int wave_s, bool with_meta) {
    LAS int* slot = (LAS int*)(lds + LDS_MISC);
    const int x0 = (int)(__builtin_amdgcn_s_getreg((3 << 11) | 20) & 7u);
    for (int q = 0; q < 8; ++q) {
        const int x = (x0 + q) & 7;
        for (;;) {
            if (wave_s == 0 && lane_id_v() == 0) slot[0] = (int)atomicAdd(ctr + 16 * x, 1u);
            __syncthreads();
            const int u = slot[0];
            __syncthreads();
            if (u >= ATT_QUEUE) break;
            const int j = u / ATT_GRP, r = u - j * ATT_GRP;
            int ty, qt, bhl;
            if (r < 64) { qt = 7 - (r >> 3); ty = ((r >> 2) & 1) ? 1 : 2; bhl = r & 3; }
            else if (r < 96) { const int v = r - 64; ty = 0; qt = v >> 2; bhl = v & 3; }
            else { if (!with_meta) continue; const int v = r - 96; ty = v >> 2; qt = -1; bhl = v & 3; }
            const int bh = 4 * (x + 8 * j) + bhl, b = bh >> 3, h = bh & 7;
            if (ty == 0) attn_unit<0>(lds, a, b, h, qt, wave_s); else if (ty == 1) attn_unit<1>(lds, a, b, h, qt, wave_s); else attn_unit<2>(lds, a, b, h, qt, wave_s);
        }
    }
}

template <int KIND> __device__ __forceinline__ int src_col(int n, float& sc) {
    sc = 1.f;
    if (KIND == 0) {
        if (n < 2304) { if (n < 512 || (n >= 768 && n < 1280)) sc = QS64; return n; }
        if (n < 3840) return 2728 + (n - 2304);
        if (n < 6912) return 4264 + (n - 3840);
        if (n < 7168) return 2312 + (n - 6912);
        if (n < 7296) return 2568 + (n - 7168);
        if (n < 7328) { const int i = n - 7296; return 2696 + ((i & 1) ? (i >> 1) + 16 : (i >> 1)); }
        if (n < 7336) return 2304 + (n - 7328);
        return -1;
    } else if (KIND == 1) {
        const int hd = n / 96, off = n - hd * 96; sc = QS96;
        if (off < 64) return n;
        const int i = off - 64; return hd * 96 + 64 + ((i & 1) ? (i >> 1) + 16 : (i >> 1));
    }
    return n;
}
template <int KIND> __device__ __forceinline__ void transpose_item(const float* W, int K, int Ns, bf16_t* WT, int item, int nblk, const float* ksc, LAS float* scr, int lane) {
    const int kb = item / nblk, nb = item - kb * nblk, k0 = 64 * kb, n0 = 32 * nb;
    float csc; const int sc_ = src_col<KIND>(n0 + (lane & 31), csc);
    const bool plain = KIND == 0 ? (n0 < 7296) : KIND == 1 ? ((n0 % 96) < 64) : true;
    if (plain) {
        float c0; const int s0 = src_col<KIND>(n0, c0);
        const int n4 = lane & 7, kr = lane >> 3;
        f32x4 v[8];
#pragma unroll
        for (int i = 0; i < 8; ++i) v[i] = *(const f32x4*)(W + (size_t)(k0 + 8 * i + kr) * Ns + s0 + 4 * n4);
#pragma unroll
        for (int i = 0; i < 8; ++i) { const int kk = 8 * i + kr; const float sc = ksc ? c0 * ksc[k0 + kk] : c0; LAS float* d = scr + kk * 33 + 4 * n4;
            d[0] = v[i][0] * sc; d[1] = v[i][1] * sc; d[2] = v[i][2] * sc; d[3] = v[i][3] * sc; }
    } else
#pragma unroll 8
    for (int i = 0; i < 32; ++i) { const int kk = 2 * i + (lane >> 5);
        float v = 0.f; if (sc_ >= 0) { v = W[(size_t)(k0 + kk) * Ns + sc_] * csc; if (ksc) v *= ksc[k0 + kk]; }
        scr[kk * 33 + (lane & 31)] = v; }
    asm volatile("s_waitcnt lgkmcnt(0)" ::: "memory");
    const int c = lane & 7;
#pragma unroll
    for (int j = 0; j < 4; ++j) { const int n = (lane >> 3) + 8 * j; const LAS float* s = scr + (8 * c) * 33 + n;
        u32x4 o; o.x = cvt_pk_bf16(s[0 * 33], s[1 * 33]); o.y = cvt_pk_bf16(s[2 * 33], s[3 * 33]); o.z = cvt_pk_bf16(s[4 * 33], s[5 * 33]); o.w = cvt_pk_bf16(s[6 * 33], s[7 * 33]);
        *(u32x4*)(WT + (size_t)(n0 + n) * K + k0 + 8 * c) = o; }
    asm volatile("s_waitcnt lgkmcnt(0)" ::: "memory");
}

#define XB_TMO      128
#define XB_XCNT(j)  (256  + 64 * (j))
#define XB_XSUB(j)  (1280 + 64 * (j))
#define XB_XGEN(j)  (2304 + 64 * (j))
#define XB_TOP      3328
#define XB_TOPGEN   3392
#define XB_SPIN_CAP (1u << 22)
__device__ __forceinline__ unsigned xb_ld(unsigned* p)              { return __hip_atomic_load(p, __ATOMIC_RELAXED, __HIP_MEMORY_SCOPE_AGENT); }
__device__ __forceinline__ unsigned xb_add(unsigned* p, unsigned v) { return __hip_atomic_fetch_add(p, v, __ATOMIC_RELAXED, __HIP_MEMORY_SCOPE_AGENT); }
#define XB_SPIN(cond, bar) do { unsigned _sp = 0; while (cond) { __builtin_amdgcn_s_sleep(1); \
    if ((++_sp & 255u) == 0u) { if (xb_ld(&(bar)[XB_TMO])) break; if (_sp > XB_SPIN_CAP) { atomicAdd(&(bar)[XB_TMO], 1u); break; } } } } while (0)
__device__ __forceinline__ void xcd_barrier_complete(unsigned* bar, unsigned x, unsigned G, unsigned& nloc, unsigned& nx) {
    unsigned sum, cnt, mine, sp = 0u;
    for (;;) {
        sum = 0u; cnt = 0u; mine = 0u;
#pragma unroll
        for (unsigned j = 0; j < 16; ++j) { const unsigned c = xb_ld(&bar[XB_XCNT(j)]); sum += c; cnt += (c > 0u) ? 1u : 0u; mine = (j == x) ? c : mine; }
        if (sum == G) break;
        __builtin_amdgcn_s_sleep(1);
        if ((++sp & 255u) == 0u) { if (xb_ld(&bar[XB_TMO])) break; if (sp > XB_SPIN_CAP) { atomicAdd(&bar[XB_TMO], 1u); break; } }
    }
    nloc = mine > 0u ? mine : 1u; nx = cnt > 0u ? cnt : 1u;
}
__device__ __forceinline__ void grid_barrier(unsigned* bar, volatile LAS unsigned* st, unsigned G, bool leader) {
    asm volatile("s_waitcnt vmcnt(0)" ::: "memory");
    __syncthreads();
    if (leader) {
        const unsigned x = (unsigned)__builtin_amdgcn_s_getreg((3 << 11) | 20) & 0xFu;
        __builtin_amdgcn_s_waitcnt(0);
        unsigned nloc = st[0], nx = st[1];
        if (nloc == 0u) { xcd_barrier_complete(bar, x, G, nloc, nx); st[0] = nloc; st[1] = nx; }
        const unsigned old = xb_add(&bar[XB_XSUB(x)], 1u);
        const unsigned gen = old / nloc;
        if (old + 1u == (gen + 1u) * nloc) {
            __builtin_amdgcn_fence(__ATOMIC_RELEASE, "agent");
            asm volatile("s_waitcnt vmcnt(0)" ::: "memory");
            const unsigned og = xb_add(&bar[XB_TOP], 1u);
            const unsigned tg = og / nx;
            if (og + 1u == (tg + 1u) * nx) xb_add(&bar[XB_TOPGEN], 1u);
            else XB_SPIN(xb_ld(&bar[XB_TOPGEN]) == tg, bar);
            __builtin_amdgcn_fence(__ATOMIC_ACQUIRE, "agent");
            xb_add(&bar[XB_XGEN(x)], 1u);
            asm volatile("s_waitcnt vmcnt(0)" ::: "memory");
        } else {
            XB_SPIN(xb_ld(&bar[XB_XGEN(x)]) == gen, bar);
            __builtin_amdgcn_fence(__ATOMIC_ACQUIRE, "agent");
            asm volatile("s_waitcnt vmcnt(0)" ::: "memory");
        }
    }
    __syncthreads();
}

struct Args { const float* in[13]; float* out; unsigned char* ws; };

__global__ void __launch_bounds__(512, 2) hybrid_fwd(Args args) {
    extern __shared__ __attribute__((aligned(16))) unsigned char lds_raw[];
    LAS unsigned char* lds = (LAS unsigned char*)lds_raw;
    cg::grid_group grid = cg::this_grid();
    grid.sync();
    const int wave = __builtin_amdgcn_readfirstlane((int)threadIdx.x >> 6);
    const int G = gridDim.x, gw = blockIdx.x * 8 + wave, NGW = G * 8;
    unsigned char* ws = args.ws;
    if (wave == 0) { const unsigned xcc_id = (unsigned)__builtin_amdgcn_s_getreg((3 << 11) | 20) & 0xFu; const int l0 = lane_id_v(); if (l0 == 0) { ((volatile LAS unsigned*)(lds + LDS_MISC + 16))[0] = 0u; ((volatile LAS unsigned*)(lds + LDS_MISC + 16))[1] = 0u;
                                                      (void)xb_add((unsigned*)(ws + WS_CTL + 8192) + XB_XCNT(xcc_id), 1u); } }
    __syncthreads();
    const float* x_in = args.in[0]; const float* meta_tok = args.in[1]; const float* norm_g = args.in[2]; const float* w_in = args.in[3]; const float* b_f = args.in[4];
    const float* sinks = args.in[5]; const float* q_norm_g = args.in[6]; const float* kv_norm_g = args.in[7]; const float* w_uq = args.in[8]; const float* w_ukv = args.in[9];
    const float* w_br = args.in[10]; const float* w_out = args.in[11]; const float* final_g = args.in[12];
    float* out = args.out;
#define GBAR() grid_barrier((unsigned*)(ws + WS_CTL + 8192), (volatile LAS unsigned*)(lds + LDS_MISC + 16), (unsigned)G, wave == 0 && lane_id_v() == 0)
#define WSB() unsigned char* wsb_ = ws; int blk = (int)blockIdx.x, Gs = G, wvl = wave; asm volatile("" : "+s"(wsb_), "+s"(blk), "+s"(Gs), "+s"(wvl)); GAS unsigned char* wsb = (GAS unsigned char*)wsb_
#define Win ((bf16_t*)(wsb + WS_WIN))
#define Wuq ((bf16_t*)(wsb + WS_WUQ))
#define Wukv ((bf16_t*)(wsb + WS_WUKV))
#define Wbr ((bf16_t*)(wsb + WS_WBR))
#define Wout ((bf16_t*)(wsb + WS_WOUT))
#define ROPE ((f32x2*)(wsb + WS_ROPE))
#define XB ((bf16_t*)(wsb + WS_XB))
#define P ((bf16_t*)(wsb + WS_P))
#define QC ((bf16_t*)(wsb + WS_QC))
#define KVC ((bf16_t*)(wsb + WS_KVC))
#define CQ ((bf16_t*)(wsb + WS_CQ))
#define YACC ((float*)(wsb + WS_YACC))
#define CKV ((bf16_t*)(wsb + WS_CKV))
#define KR ((bf16_t*)(wsb + WS_KR))
#define BFL ((float*)(wsb + WS_BFL))
#define FC ((float*)(wsb + WS_FC))
#define OZ ((bf16_t*)(wsb + WS_OZ))
#define Y ((bf16_t*)(wsb + WS_Y))
#define XM ((float*)(wsb + WS_XM))
#define SSQX ((float*)(wsb + WS_SSQX))
#define SSQQ ((float*)(wsb + WS_SSQQ))
#define SSQKV ((float*)(wsb + WS_SSQKV))

    {
        WSB();
        const int lane = lane_id_v(), tid = wave * 64 + lane;
        LAS float* scr = (LAS float*)(lds + wave * 16384);
        constexpr int I_IN = (D / 64) * (NIN / 32), I_UQ = (256 / 64) * (768 / 32), I_UKV = (128 / 64) * (1024 / 32), I_BR = 3 * (512 / 64) * (1024 / 32), I_OUT = (1024 / 64) * (1024 / 32);
        constexpr int I_L = I_IN + I_UQ + I_UKV + I_BR + I_OUT;
        for (int it = gw; it < DEPTH * I_L; it += NGW) {
            const int l = it / I_L; int r = it - l * I_L;
            if (r < I_IN) { transpose_item<0>(w_in + (size_t)l * D * DIN, D, DIN, Win + (size_t)l * NIN * D, r, NIN / 32, norm_g + l * D, scr, lane); continue; } r -= I_IN;
            if (r < I_UQ) { transpose_item<1>(w_uq + (size_t)l * 256 * 768, 256, 768, Wuq + (size_t)l * 768 * 256, r, 768 / 32, q_norm_g + l * 256, scr, lane); continue; } r -= I_UQ;
            if (r < I_UKV) { transpose_item<2>(w_ukv + (size_t)l * 128 * 1024, 128, 1024, Wukv + (size_t)l * 1024 * 128, r, 1024 / 32, kv_norm_g + l * 128, scr, lane); continue; } r -= I_UKV;
            if (r < I_BR) { const int z = r / (I_BR / 3), rr = r - z * (I_BR / 3);
                transpose_item<2>(w_br + ((size_t)l * 3 + z) * 512 * 1024, 512, 1024, Wbr + ((size_t)l * 3 + z) * 1024 * 512, rr, 1024 / 32, nullptr, scr, lane); continue; } r -= I_BR;
            transpose_item<2>(w_out + (size_t)l * 1024 * 1024, 1024, 1024, Wout + (size_t)l * 1024 * 1024, r, 1024 / 32, nullptr, scr, lane);
        }
        for (int i = blockIdx.x * 512 + tid; i < NPOS * 16; i += G * 512) {
            const int p = i >> 4, j = i & 15;
            const double inv = pow(10000.0, -(double)j / 16.0), ang = (double)p * inv;
            ROPE[i] = (f32x2){(float)cos(ang), (float)sin(ang)};
        }
    }

    for (int chunk = 0; chunk < NCHUNK; ++chunk) {
        const int Mc = chunk == 0 ? MC : MR;
        const float* x_chunk = x_in + (size_t)chunk * MR * D;
        float* out_chunk = out + (size_t)chunk * MR * D;
        { WSB(); const int lane = lane_id_v();
        for (int m = gw; m < Mc; m += 2 * NGW) {
            const int mb = (m + NGW < Mc) ? m + NGW : m;
            const float* xr = m < MR ? x_chunk + (size_t)m * D : meta_tok + (size_t)((m - MR) & (NMETA - 1)) * D;
            const float* xs = mb < MR ? x_chunk + (size_t)mb * D : meta_tok + (size_t)((mb - MR) & (NMETA - 1)) * D;
            const f32x4* xv = (const f32x4*)xr + lane; const f32x4* xw = (const f32x4*)xs + lane; f32x4 v[4], w[4]; float s = 0.f, t = 0.f;
#pragma unroll
            for (int j = 0; j < 4; ++j) { v[j] = xv[64 * j]; w[j] = xw[64 * j]; }
#pragma unroll
            for (int j = 0; j < 4; ++j) { s += (v[j][0] * v[j][0] + v[j][1] * v[j][1]) + (v[j][2] * v[j][2] + v[j][3] * v[j][3]); t += (w[j][0] * w[j][0] + w[j][1] * w[j][1]) + (w[j][2] * w[j][2] + w[j][3] * w[j][3]); }
            s = wave_sum(s, lane); t = wave_sum(t, lane);
            u32x2* o8 = (u32x2*)(XB + ((size_t)chunk * MC + m) * D) + lane; u32x2* p8 = (u32x2*)(XB + ((size_t)chunk * MC + mb) * D) + lane;
#pragma unroll
            for (int j = 0; j < 4; ++j) { u32x2 a; a.x = cvt_pk_bf16(v[j][0], v[j][1]); a.y = cvt_pk_bf16(v[j][2], v[j][3]); o8[64 * j] = a;
                                          u32x2 c; c.x = cvt_pk_bf16(w[j][0], w[j][1]); c.y = cvt_pk_bf16(w[j][2], w[j][3]); p8[64 * j] = c; }
            if (lane < 16) { SSQX[((size_t)chunk * MC + m) * 16 + lane] = lane == 0 ? s : 0.f; SSQX[((size_t)chunk * MC + mb) * 16 + lane] = lane == 0 ? t : 0.f; }
        } }
    }
    GBAR();
    for (int l = 0; l < DEPTH; ++l) {
      for (int chunk = 0; chunk < NCHUNK; ++chunk) {
        const int Mc = chunk == 0 ? MC : MR;
        const float* x_chunk = x_in + (size_t)chunk * MR * D;
        float* out_chunk = out + (size_t)chunk * MR * D;
            {
                WSB();
                pg8::Gemm g{XB + (size_t)chunk * MC * 1024, Win + (size_t)l * NIN * D, Mc, NIN, D, 0, 0};
                pg8::StaticOrder S; S.init(Mc, NIN, Gs, blk, 1);
                EpiIn E{P, CQ, CKV, KR, BFL, SSQX + (size_t)chunk * MC * 16, SSQQ, SSQKV, ROPE, lds};
                pg8::gemm_phase(lds, g, S, E, wvl);
            }
            GBAR();
            if (gw < CB * 8) {
                WSB(); const int lane = lane_id_v();
                const int b = gw >> 3, h = gw & 7; const float bf = b_f[l * 8 + h];
                const int p0 = 33 * lane;
                float lf[33];
#pragma unroll
                for (int i = 0; i < 33; ++i) { const int p = (p0 + i < NPOS) ? p0 + i : NPOS - 1; const int row = p < NMETA ? MR + b * NMETA + p : b * T + (p - NMETA);
                    lf[i] = BFL[(size_t)row * 8 + h]; }
                float tot = 0.f;
#pragma unroll
                for (int i = 0; i < 33; ++i) { const float xv = lf[i] + bf; const float v = fminf(xv, 0.f) - __logf(1.0f + __expf(-fabsf(xv))); lf[i] = (p0 + i < NPOS) ? v : 0.f; tot += lf[i]; }
                float inc = tot;
#pragma unroll
                for (int o = 1; o < 64; o <<= 1) { const float t = __int_as_float(__builtin_amdgcn_ds_bpermute(((lane - o) & 63) << 2, __float_as_int(inc))); if (lane >= o) inc += t; }
                float run = inc - tot;
#pragma unroll
                for (int i = 0; i < 33; ++i) { const int p = p0 + i; run += lf[i];
                    if (p < NPOS) { const int row = p < NMETA ? MR + b * NMETA + p : b * T + (p - NMETA); FC[(size_t)row * 8 + h] = run * LOG2E; } }
            }
            {
                WSB();
                pg8::Gemm g{CQ, Wuq + (size_t)l * 768 * 256, Mc, 768, 256, 0, 0};
                pg8::StaticOrder S; S.init(Mc, 768, Gs, blk, 1);
                EpiUp<false> E{QC, 768, SSQQ, 1.0f / 256.0f, ROPE, lds};
                pg8::gemm_phase(lds, g, S, E, wvl);
            }
            {
                WSB();
                pg8::Gemm g{CKV, Wukv + (size_t)l * 1024 * 128, Mc, 1024, 128, 0, 0};
                pg8::StaticOrder S; S.init(Mc, 1024, Gs, Gs == 256 ? ((blk + 120) & 255) : blk, 1);
                EpiUp<false> E{KVC, 1024, SSQKV, 1.0f / 128.0f, ROPE, lds};
                pg8::gemm_phase(lds, g, S, E, wvl);
            }
            GBAR();
            {
                WSB();
                AttnArgs a{P, QC, KVC, KR, FC, OZ, sinks + l * 8, ROPE};
                attn_phase(lds, a, (unsigned*)(wsb + WS_CTL) + 128 * (chunk * DEPTH + l), wvl, chunk == 0);
            }
            GBAR();
            {
                WSB();
                pg8::Gemm g{OZ, Wbr + (size_t)l * 3 * 1024 * 512, Mc, 1024, 512, (size_t)MC * 512, (size_t)1024 * 512};
                pg8::StaticOrder S; S.init(Mc, 1024, Gs, blk, 3, 128);
                EpiBr E{P, Y};
                pg8::gemm_phase<EpiBr, pg8::StaticOrder, true>(lds, g, S, E, wvl);
            }
            GBAR();
            {
                WSB();
                pg8::Gemm g{Y, Wout + (size_t)l * 1024 * 1024, Mc, 1024, 1024, 0, 0};
                pg8::StaticOrder S; S.init(Mc, 1024, Gs, blk, 1);
                EpiOut E{l == 0 ? x_chunk : out_chunk, l == 0 ? meta_tok : XM, l == 0 ? (NMETA - 1) : 0x7fffffff, out_chunk, XM, XB + (size_t)chunk * MC * 1024, SSQX + (size_t)chunk * MC * 16, l < DEPTH - 1};
                pg8::gemm_phase(lds, g, S, E, wvl);
            }
            if (l == DEPTH - 1 && chunk == NCHUNK - 1) GBAR();
      }
    }
    for (int chunk = 0; chunk < NCHUNK; ++chunk) {
        float* out_chunk = out + (size_t)chunk * MR * D;
        const int lane = lane_id_v();
        for (int m = gw; m < MR; m += 2 * NGW) {
            const int mb = (m + NGW < MR) ? m + NGW : m;
            f32x4* xv = (f32x4*)(out_chunk + (size_t)m * D) + lane; f32x4* xw = (f32x4*)(out_chunk + (size_t)mb * D) + lane; f32x4 v[4], w[4]; float s = 0.f, t = 0.f;
#pragma unroll
            for (int j = 0; j < 4; ++j) { v[j] = xv[64 * j]; w[j] = xw[64 * j]; }
#pragma unroll
            for (int j = 0; j < 4; ++j) { s += (v[j][0] * v[j][0] + v[j][1] * v[j][1]) + (v[j][2] * v[j][2] + v[j][3] * v[j][3]); t += (w[j][0] * w[j][0] + w[j][1] * w[j][1]) + (w[j][2] * w[j][2] + w[j][3] * w[j][3]); }
            s = wave_sum(s, lane); t = wave_sum(t, lane);
            const float rs = __builtin_amdgcn_rsqf(s * (1.0f / 1024.0f) + EPS), rt = __builtin_amdgcn_rsqf(t * (1.0f / 1024.0f) + EPS);
#pragma unroll
            for (int j = 0; j < 4; ++j) { const f32x4 gv = ((const f32x4*)final_g)[64 * j + lane]; xv[64 * j] = v[j] * rs * gv; if (mb != m) xw[64 * j] = w[j] * rt * gv; }
        }
    }
}

extern "C" void kernel_launch(void* const* d_in, const int* in_sizes, int n_in, void* d_out, int out_size, void* d_ws, size_t ws_size, hipStream_t stream) {
    static int grid = 0;
    if (grid == 0) {
        if (n_in != 13 || ws_size < WS_END) { fprintf(stderr, "kernel_launch: bad inputs (n_in %d, ws %zu < %zu)\n", n_in, ws_size, (size_t)WS_END); grid = -1; return; }
        int dev = 0, cus = 0, per_cu = 0;
        hipGetDevice(&dev); hipDeviceGetAttribute(&cus, hipDeviceAttributeMultiprocessorCount, dev);
        hipFuncSetAttribute((const void*)hybrid_fwd, hipFuncAttributeMaxDynamicSharedMemorySize, LDS_BYTES);
        hipOccupancyMaxActiveBlocksPerMultiprocessor(&per_cu, (const void*)hybrid_fwd, 512, LDS_BYTES);
        if (per_cu < 1) { fprintf(stderr, "kernel_launch: occupancy query says %d blocks per CU\n", per_cu); per_cu = 1; }
        (void)hipGetLastError();
        grid = cus;
    }
    if (grid < 0) return;
    hipMemsetAsync((char*)d_ws + WS_CTL, 0, CTL_BYTES, stream);
    Args a{};
    for (int i = 0; i < 13; ++i) a.in[i] = (const float*)d_in[i];
    a.out = (float*)d_out; a.ws = (unsigned char*)d_ws;
    void* kargs[] = {&a};
    hipError_t e = hipLaunchCooperativeKernel((const void*)hybrid_fwd, dim3(grid), dim3(512), kargs, LDS_BYTES, stream);
    if (e != hipSuccess) fprintf(stderr, "cooperative launch failed: %s (grid %d)\n", hipGetErrorString(e), grid);
}
```
